# Optimizing an MI355X kernel written in HIP

```python
import math
import jax, jax.numpy as jnp
from jax import lax
import numpy as np

D_MODEL = 1024
BATCH = 16
SEQ = 2048
DEPTH = 1

HEAD_DIM = 64
SB_HEADS = 8
SG_GROUPS = 8
SB_WIDTH = SB_HEADS * HEAD_DIM
SG_WIDTH = SG_GROUPS * HEAD_DIM
MIX_WIDTH = SB_WIDTH + SG_WIDTH
IN_WIDTH = 3 * SB_WIDTH + 2 * SG_WIDTH
Q_BLOCK = 128
CHUNK = 128
D_FF = 4 * D_MODEL
EPS = 1e-6

kernel_name = "hybrid_stickbreak_spatialgate_block"


def rms_norm(x, g):
    x32 = x.astype(jnp.float32)
    r = x32 * lax.rsqrt(jnp.mean(x32 * x32, axis=-1, keepdims=True) + EPS)
    return (r * g.astype(jnp.float32)).astype(x.dtype)


def stick_breaking_attention(q, k, v):
    B, H, S, Dh = q.shape
    scale = 1.0 / math.sqrt(Dh)
    outs = []
    for i in range(S // Q_BLOCK):
        k_end = (i + 1) * Q_BLOCK
        qb = q[:, :, i * Q_BLOCK:k_end]
        kb = k[:, :, :k_end]
        vb = v[:, :, :k_end]
        z = jnp.einsum('bhtd,bhsd->bhts', qb, kb).astype(jnp.float32) * scale
        t_pos = i * Q_BLOCK + jnp.arange(Q_BLOCK)[:, None]
        s_pos = jnp.arange(k_end)[None, :]
        mask = s_pos < t_pos
        log1m = jnp.where(mask, jax.nn.log_sigmoid(-z), 0.0)
        excl = lax.cumsum(log1m, axis=3, reverse=True) - log1m
        log_a = jax.nn.log_sigmoid(z) + excl
        a = jnp.where(mask, jnp.exp(log_a), 0.0)
        outs.append(jnp.einsum('bhts,bhsd->bhtd', a.astype(vb.dtype), vb))
    return jnp.concatenate(outs, axis=2)


def spatial_gating(u, v, w_s, b_s, v_norm_g):
    B, S, G, Dh = v.shape
    v = rms_norm(v, v_norm_g)
    vc = v.reshape(B, S // CHUNK, CHUNK, G, Dh)
    causal = jnp.tril(jnp.ones((CHUNK, CHUNK), dtype=bool))
    w = jnp.where(causal[None], w_s, 0.0).astype(v.dtype)
    y = jnp.einsum('gts,bcsgd->bctgd', w, vc)
    y = y + jnp.transpose(b_s)[None, None, :, :, None].astype(v.dtype)
    return u * y.reshape(B, S, G, Dh)


def setup_inputs(seed: int = 0) -> dict:
    key = jax.random.key(seed)
    ks = jax.random.split(key, 20)
    f = jnp.float32
    n = lambda k, shape, s: jax.random.normal(k, shape, f) * s
    inp = {
        "x": n(ks[0], (BATCH, SEQ, D_MODEL), 1.0),
        "norm1_g": 1.0 + n(ks[1], (D_MODEL,), 0.02),
        "w_in": n(ks[2], (D_MODEL, IN_WIDTH), D_MODEL ** -0.5),
        "q_norm_g": 1.0 + n(ks[3], (HEAD_DIM,), 0.02),
        "k_norm_g": 1.0 + n(ks[4], (HEAD_DIM,), 0.02),
        "sg_v_norm_g": 1.0 + n(ks[5], (HEAD_DIM,), 0.02),
        "sg_w": n(ks[6], (SG_GROUPS, CHUNK, CHUNK), CHUNK ** -0.5),
        "sg_b": 1.0 + n(ks[7], (SG_GROUPS, CHUNK), 0.01),
        "sb_out_norm_g": 1.0 + n(ks[8], (HEAD_DIM,), 0.02),
        "sg_out_norm_g": 1.0 + n(ks[9], (HEAD_DIM,), 0.02),
        "w_out": n(ks[10], (MIX_WIDTH, D_MODEL), MIX_WIDTH ** -0.5),
        "norm2_g": 1.0 + n(ks[11], (D_MODEL,), 0.02),
        "w_ff1": n(ks[12], (D_MODEL, D_FF), D_MODEL ** -0.5),
        "w_ff2": n(ks[13], (D_FF, D_MODEL), D_FF ** -0.5),
    }
    return inp


def reference(x, norm1_g, w_in, q_norm_g, k_norm_g, sg_v_norm_g, sg_w, sg_b,
              sb_out_norm_g, sg_out_norm_g, w_out, norm2_g, w_ff1, w_ff2):
    B, S, _ = x.shape
    h = x
    for _layer in range(DEPTH):
        xn = rms_norm(h, norm1_g)
        proj = jnp.einsum('bsd,de->bse', xn, w_in)
        q, k, v, u_sg, v_sg = jnp.split(
            proj, np.cumsum([SB_WIDTH, SB_WIDTH, SB_WIDTH, SG_WIDTH]).tolist(), axis=-1)
        q = rms_norm(q.reshape(B, S, SB_HEADS, HEAD_DIM), q_norm_g)
        k = rms_norm(k.reshape(B, S, SB_HEADS, HEAD_DIM), k_norm_g)
        v = v.reshape(B, S, SB_HEADS, HEAD_DIM)
        o_sb = stick_breaking_attention(q.transpose(0, 2, 1, 3), k.transpose(0, 2, 1, 3),
                                        v.transpose(0, 2, 1, 3)).transpose(0, 2, 1, 3)
        o_sb = rms_norm(o_sb, sb_out_norm_g)
        o_sg = spatial_gating(u_sg.reshape(B, S, SG_GROUPS, HEAD_DIM),
                              v_sg.reshape(B, S, SG_GROUPS, HEAD_DIM),
                              sg_w, sg_b, sg_v_norm_g)
        o_sg = rms_norm(o_sg, sg_out_norm_g)
        mix = jnp.concatenate([o_sb.reshape(B, S, SB_WIDTH),
                               o_sg.reshape(B, S, SG_WIDTH)], axis=-1)
        h = h + jnp.einsum('bse,ed->bsd', mix, w_out)
        hn = rms_norm(h, norm2_g)
        a = jax.nn.relu(jnp.einsum('bsd,df->bsf', hn, w_ff1))
        h = h + jnp.einsum('bsf,fd->bsd', a * a, w_ff2)
    return h
```

```cpp
#include <hip/hip_runtime.h>
#include <cstdio>
#include <cstdint>
#ifndef PG8_RELAX
#define PG8_RELAX true
#endif
namespace pg8 {
#define PG8_LAS __attribute__((address_space(3)))
typedef unsigned short bf16_t;
typedef short bf16x8 __attribute__((ext_vector_type(8)));
typedef float f32x4 __attribute__((ext_vector_type(4)));
typedef unsigned u32x4 __attribute__((ext_vector_type(4)));
constexpr int BM = 256, BK = 64, HALF = 128, HTB = HALF * BK * 2  , STAGE_BYTES = 8 * HTB, NXCD = 8, WGM = 8;

__host__ __device__ __forceinline__ int lds_byte(int r, int c) { const int st = (r >> 4) * 2 + (c >> 5), rr = r & 15, cc = c & 31, ob = rr * 64 + cc * 2; return st * 1024 + (ob ^ (((ob >> 9) & 1) << 5)); }
__host__ __device__ __forceinline__ void stage_rc(int b, int& R, int& C) { const int st = b / 1024, sb = b % 1024, swz = sb ^ (((sb >> 9) & 1) << 5); R = (st >> 1) * 16 + swz / 64; C = (st & 1) * 32 + (swz % 64) / 2; }
__host__ __device__ __forceinline__ int perm32(int rho) { const int n = rho >> 4, i = rho & 15; return 8 * (i >> 2) + 4 * n + (i & 3); }

struct Unit { int pm, pn; };
struct Gemm { const bf16_t* A; const bf16_t* Bt; int M, N, K; };

struct StaticOrder {
    int nM, nN, nwg, G, c;
    __host__ __device__ void init(int M, int N, int G_, int c_) { nM = M / BM; nN = N / BM; nwg = nM * nN; G = G_; c = c_; }
    __host__ __device__ bool next(int i, Unit& u) const {
        const long L = (long)i * G + c; if (L >= nwg) return false;
        int wgid = (int)L; { const int q = nwg / NXCD, r = nwg % NXCD, xcd = wgid % NXCD, off = wgid / NXCD; wgid = (xcd < r ? xcd * (q + 1) : r * (q + 1) + (xcd - r) * q) + off; }
        const int nig = WGM * nN, gid = wgid / nig, fm = gid * WGM, gsz = (nM - fm) < WGM ? (nM - fm) : WGM;
        u.pm = fm + ((wgid % nig) % gsz); u.pn = (wgid % nig) / gsz; return true;
    }
    __device__ __forceinline__ void a_ready(const Unit&) const {}
    __device__ __forceinline__ void done(const Unit&) const {}
};

__device__ __forceinline__ unsigned cvt_pk_bf16(float lo, float hi) { unsigned r; asm volatile("v_cvt_pk_bf16_f32 %0, %1, %2" : "=v"(r) : "v"(lo), "v"(hi)); return r; }
typedef float f32x2 __attribute__((ext_vector_type(2)));
typedef float f32x2 __attribute__((ext_vector_type(2)));
typedef unsigned u32x2 __attribute__((ext_vector_type(2)));

__device__ __forceinline__ void stage_store16(PG8_LAS unsigned char* stg, bf16_t* row0p  , size_t pitch  , int fr, int c0, int c1  , const u32x4& w0, const u32x4& w1) {
    const int lane = threadIdx.x & 63;
    *(PG8_LAS u32x4*)(stg + fr * 128 + ((c0 ^ (fr & 7)) * 16)) = w0;
    *(PG8_LAS u32x4*)(stg + fr * 128 + ((c1 ^ (fr & 7)) * 16)) = w1;
    asm volatile("" ::: "memory");
#pragma unroll
    for (int i = 0; i < 2; ++i) { const int row = i * 8 + (lane >> 3), ch = lane & 7;
        const u32x4 v = *(const PG8_LAS u32x4*)(stg + row * 128 + ((ch ^ (row & 7)) * 16));
        *(u32x4*)(row0p + (size_t)row * pitch + ch * 8) = v; }
    asm volatile("" ::: "memory");
}
struct EpiProj {
    static constexpr bool PERM = true, AFTER_DRAIN = false; static constexpr int NSTORE = 16;
    bf16_t* base; size_t sec_stride; const float* gq; const float* gk; const float* gvs; const float* rs1; PG8_LAS unsigned char* stg;
    struct Pre { float r1[2][4]; };
    __device__ __forceinline__ Pre prefetch(const Unit& u, int wr, int, int fr, int) const { Pre p;
#pragma unroll
        for (int ai = 0; ai < 2; ++ai)
#pragma unroll
            for (int m = 0; m < 4; ++m) p.r1[ai][m] = rs1[u.pm * BM + ai * HALF + wr * 64 + m * 16 + fr];
        return p; }
    __device__ __forceinline__ void operator()(const f32x4 (&acc)[2][2][4][2], const Unit& u, int wr, int wc, int fr, int fq, const Pre& pre) const {
        const int sec = u.pn >> 1;
        bf16_t* O = base + (size_t)sec * sec_stride;
        const int col0 = (u.pn & 1) * 256 + wc * 64 + 8 * fq;
        const float *ga = gq, *gb = gk, *gc = gvs;
        asm volatile("" : "+s"(ga), "+s"(gb), "+s"(gc));
        const float* g = sec == 0 ? ga : (sec == 1 ? gb : gc);
        const bool nrm = (sec == 0) || (sec == 1) || (sec == 4);
        const float post = sec == 0 ? 0.18033688011112042f : 1.0f;
        f32x4 gv[2][2];
#pragma unroll
        for (int bj = 0; bj < 2; ++bj)
#pragma unroll
            for (int n = 0; n < 2; ++n) gv[bj][n] = nrm ? *(const f32x4*)(g + 32 * bj + 8 * fq + 4 * n) * post : (f32x4){1.f, 1.f, 1.f, 1.f};
        float r1v[2][4];
#pragma unroll
        for (int ai = 0; ai < 2; ++ai)
#pragma unroll
            for (int m = 0; m < 4; ++m) r1v[ai][m] = pre.r1[ai][m];
#pragma unroll
        for (int ai = 0; ai < 2; ++ai)
#pragma unroll
            for (int m = 0; m < 4; ++m) {
                const float r1 = r1v[ai][m]; float rs = r1;
                if (nrm) {
                    float s = 0.f;
#pragma unroll
                    for (int bj = 0; bj < 2; ++bj)
#pragma unroll
                        for (int n = 0; n < 2; ++n) { const f32x4 x = acc[ai][bj][m][n]; s += (x[0] * x[0] + x[1] * x[1]) + (x[2] * x[2] + x[3] * x[3]); }
                    s += __shfl_xor(s, 16); s += __shfl_xor(s, 32);
                    rs = __builtin_amdgcn_rsqf(s * (r1 * r1) * (1.0f / 64.0f) + 1e-6f) * r1;
                }
                u32x4 w[2];
#pragma unroll
                for (int bj = 0; bj < 2; ++bj) {
                    const f32x4 v0 = acc[ai][bj][m][0] * rs * gv[bj][0], v1 = acc[ai][bj][m][1] * rs * gv[bj][1];
                    w[bj].x = cvt_pk_bf16(v0[0], v0[1]); w[bj].y = cvt_pk_bf16(v0[2], v0[3]); w[bj].z = cvt_pk_bf16(v1[0], v1[1]); w[bj].w = cvt_pk_bf16(v1[2], v1[3]);
                }
                stage_store16(stg + (wr * 4 + wc) * 2048, O + (size_t)(u.pm * BM + ai * HALF + wr * 64 + m * 16) * 512 + (u.pn & 1) * 256 + wc * 64, 512, fr, fq, 4 + fq, w[0], w[1]);
            }
    }
};

struct EpiOut {
    static constexpr bool PERM = true, AFTER_DRAIN = false; static constexpr int NSTORE = 16;
    const bf16_t* xb; bf16_t* hb; float* rowss; PG8_LAS unsigned char* stg;
    struct Pre {}; __device__ __forceinline__ Pre prefetch(const Unit&, int, int, int, int) const { return Pre{}; }
    __device__ __forceinline__ void operator()(const f32x4 (&acc)[2][2][4][2], const Unit& u, int wr, int wc, int fr, int fq, const Pre&) const {
        const int col0 = u.pn * BM + wc * 64 + 8 * fq;
        u32x4 xv[2][4][2];
#pragma unroll
        for (int ai = 0; ai < 2; ++ai)
#pragma unroll
            for (int m = 0; m < 4; ++m) { const size_t off = (size_t)(u.pm * BM + ai * HALF + wr * 64 + m * 16 + fr) * 1024 + col0;
#pragma unroll
                for (int bj = 0; bj < 2; ++bj) xv[ai][m][bj] = *(const u32x4*)(xb + off + bj * 32); }
#pragma unroll
        for (int ai = 0; ai < 2; ++ai)
#pragma unroll
            for (int m = 0; m < 4; ++m) {
                const int row = u.pm * BM + ai * HALF + wr * 64 + m * 16 + fr; float s = 0.f; u32x4 w[2];
#pragma unroll
                for (int bj = 0; bj < 2; ++bj) {
                    const u32x4 xw = xv[ai][m][bj];
                    const f32x4 h0 = (f32x4){__uint_as_float(xw.x << 16), __uint_as_float(xw.x & 0xffff0000u), __uint_as_float(xw.y << 16), __uint_as_float(xw.y & 0xffff0000u)} + acc[ai][bj][m][0];
                    const f32x4 h1 = (f32x4){__uint_as_float(xw.z << 16), __uint_as_float(xw.z & 0xffff0000u), __uint_as_float(xw.w << 16), __uint_as_float(xw.w & 0xffff0000u)} + acc[ai][bj][m][1];
                    s += (h0[0] * h0[0] + h0[1] * h0[1]) + (h0[2] * h0[2] + h0[3] * h0[3]) + (h1[0] * h1[0] + h1[1] * h1[1]) + (h1[2] * h1[2] + h1[3] * h1[3]);
                    w[bj].x = cvt_pk_bf16(h0[0], h0[1]); w[bj].y = cvt_pk_bf16(h0[2], h0[3]); w[bj].z = cvt_pk_bf16(h1[0], h1[1]); w[bj].w = cvt_pk_bf16(h1[2], h1[3]);
                }
                stage_store16(stg + (wr * 4 + wc) * 2048, hb + (size_t)(row - fr) * 1024 + u.pn * BM + wc * 64, 1024, fr, fq, 4 + fq, w[0], w[1]);
                s += __shfl_xor(s, 16); s += __shfl_xor(s, 32);
                if (fq == 0) atomicAdd(rowss + row, s);
            }
    }
};

struct EpiFF1 {
    static constexpr bool PERM = true, AFTER_DRAIN = false; static constexpr int NSTORE = 16;
    bf16_t* O; const float* rowss; PG8_LAS unsigned char* stg;
    struct Pre { float ss[2][4]; };
    __device__ __forceinline__ Pre prefetch(const Unit& u, int wr, int, int fr, int) const { Pre p;
#pragma unroll
        for (int ai = 0; ai < 2; ++ai)
#pragma unroll
            for (int m = 0; m < 4; ++m) p.ss[ai][m] = rowss[u.pm * BM + ai * HALF + wr * 64 + m * 16 + fr];
        return p; }
    __device__ __forceinline__ void operator()(const f32x4 (&acc)[2][2][4][2], const Unit& u, int wr, int wc, int fr, int fq, const Pre& pre) const {
        const int col0 = u.pn * BM + wc * 32 + 8 * fq;
        float ssv[2][4];
#pragma unroll
        for (int ai = 0; ai < 2; ++ai)
#pragma unroll
            for (int m = 0; m < 4; ++m) ssv[ai][m] = pre.ss[ai][m];
#pragma unroll
        for (int ai = 0; ai < 2; ++ai)
#pragma unroll
            for (int m = 0; m < 4; ++m) {
                const int row = u.pm * BM + ai * HALF + wr * 64 + m * 16 + fr;
                const float rs2 = __builtin_amdgcn_rcpf(ssv[ai][m] * (1.0f / 1024.0f) + 1e-6f);
                u32x4 w[2];
#pragma unroll
                for (int bj = 0; bj < 2; ++bj) {
                    f32x4 v0 = acc[ai][bj][m][0], v1 = acc[ai][bj][m][1];
#pragma unroll
                    for (int e = 0; e < 4; ++e) { const float a = fmaxf(v0[e], 0.f), b = fmaxf(v1[e], 0.f); v0[e] = a * a * rs2; v1[e] = b * b * rs2; }
                    w[bj].x = cvt_pk_bf16(v0[0], v0[1]); w[bj].y = cvt_pk_bf16(v0[2], v0[3]); w[bj].z = cvt_pk_bf16(v1[0], v1[1]); w[bj].w = cvt_pk_bf16(v1[2], v1[3]);
                }
                stage_store16(stg + (wr * 4 + wc) * 2048, O + (size_t)(row - fr) * 4096 + u.pn * BM + wc * 64, 4096, fr, fq, 4 + fq, w[0], w[1]);
            }
    }
};

struct EpiFF2 {
    static constexpr bool PERM = true, AFTER_DRAIN = false; static constexpr int NSTORE = 32;
    float* out; const bf16_t* hb; PG8_LAS unsigned char* stg;
    struct Pre {}; __device__ __forceinline__ Pre prefetch(const Unit&, int, int, int, int) const { return Pre{}; }
    __device__ __forceinline__ void operator()(const f32x4 (&acc)[2][2][4][2], const Unit& u, int wr, int wc, int fr, int fq, const Pre&) const {
        const int col0 = u.pn * BM + wc * 32 + 8 * fq;
        u32x4 hv[2][4][2];
#pragma unroll
        for (int ai = 0; ai < 2; ++ai)
#pragma unroll
            for (int m = 0; m < 4; ++m) { const size_t off = (size_t)(u.pm * BM + ai * HALF + wr * 64 + m * 16 + fr) * 1024 + col0;
#pragma unroll
                for (int bj = 0; bj < 2; ++bj) hv[ai][m][bj] = *(const u32x4*)(hb + off + bj * HALF); }
#pragma unroll
        for (int ai = 0; ai < 2; ++ai)
#pragma unroll
            for (int m = 0; m < 4; ++m) { const size_t off = (size_t)(u.pm * BM + ai * HALF + wr * 64 + m * 16 + fr) * 1024 + col0;
#pragma unroll
                for (int bj = 0; bj < 2; ++bj) { const u32x4 hw = hv[ai][m][bj];
                    const f32x4 h0 = (f32x4){__uint_as_float(hw.x << 16), __uint_as_float(hw.x & 0xffff0000u), __uint_as_float(hw.y << 16), __uint_as_float(hw.y & 0xffff0000u)};
                    const f32x4 h1 = (f32x4){__uint_as_float(hw.z << 16), __uint_as_float(hw.z & 0xffff0000u), __uint_as_float(hw.w << 16), __uint_as_float(hw.w & 0xffff0000u)};
                    const f32x4 r0 = h0 + acc[ai][bj][m][0], r1 = h1 + acc[ai][bj][m][1];
                    stage_store16(stg + (wr * 4 + wc) * 2048, (bf16_t*)(out + (off - fr * 1024 - 8 * fq) + bj * HALF), 2048, fr, 2 * fq, 2 * fq + 1, __builtin_bit_cast(u32x4, r0), __builtin_bit_cast(u32x4, r1)); } }
    }
};

template <class Epi, class Sched, bool ALIGN_EPI = false, bool SP2 = false>
__device__ __forceinline__ void gemm_phase(PG8_LAS unsigned char* lds, const Gemm g, const Sched& S, const Epi& E) {
    const int tid = threadIdx.x, wid = __builtin_amdgcn_readfirstlane(tid >> 6), lane = tid & 63, wr = wid >> 2, wc = wid & 3, fr = lane & 15, fq = lane >> 4;
    const int K = g.K, nt = K / BK;
    unsigned voffA[2], voffB[2];
#pragma unroll
    for (int i = 0; i < 2; ++i) { int R, C; stage_rc(tid * 16 + i * 8192, R, C); const int Rb = Epi::PERM ? ((R & ~31) + perm32(R & 31)) : R;
        voffA[i] = (unsigned)(R * K + C) * 2u; voffB[i] = (unsigned)(Rb * K + C) * 2u; }
    const size_t kstep = (size_t)(BK * 2);
    const size_t hstep = (size_t)HALF * K * 2;
    const size_t tstep = 2 * hstep;
    const unsigned ldsw = (unsigned)wid * 1024u;
    const int aoff = lds_byte(wr * 64 + fr, fq * 8), boff = lds_byte(wc * 32 + fr, fq * 8);
#define PG8_SA(b, h) (((b) * 2 + (h)) * HTB)
#define PG8_SB(b, h) ((4 + (b) * 2 + (h)) * HTB)
#define PG8_STAGE(bufoff, gbase, voff) do { _Pragma("unroll") for (int _i = 0; _i < 2; ++_i) \
        __builtin_amdgcn_global_load_lds((const unsigned*)((const char*)(gbase) + (voff)[_i]), (PG8_LAS unsigned*)(lds + (bufoff) + ldsw + _i * 8192), 16, 0, 0); } while (0)
#define PG8_LDA(dst, b, h) do { _Pragma("unroll") for (int m = 0; m < 4; ++m) _Pragma("unroll") for (int k = 0; k < 2; ++k) dst[m][k] = *(const PG8_LAS bf16x8*)(lds + PG8_SA(b, h) + aoff + m * 2048 + k * 1024); } while (0)
#define PG8_LDB(dst, b, h) do { _Pragma("unroll") for (int n = 0; n < 2; ++n) _Pragma("unroll") for (int k = 0; k < 2; ++k) dst[n][k] = *(const PG8_LAS bf16x8*)(lds + PG8_SB(b, h) + boff + n * 2048 + k * 1024); } while (0)
#define PG8_MMA(ai, bj, At, Bt) do { __builtin_amdgcn_s_setprio(1); _Pragma("unroll") for (int m = 0; m < 4; ++m) _Pragma("unroll") for (int n = 0; n < 2; ++n) _Pragma("unroll") for (int k = 0; k < 2; ++k) \
        acc[ai][bj][m][n] = __builtin_amdgcn_mfma_f32_16x16x32_bf16(Bt[n][k], At[m][k], acc[ai][bj][m][n], 0, 0, 0); __builtin_amdgcn_s_setprio(0); } while (0)
#define PG8_WAIT_V(n) asm volatile("s_waitcnt vmcnt(" #n ")" ::: "memory")
#define PG8_WAIT_L(n) asm volatile("s_waitcnt lgkmcnt(" #n ")" ::: "memory")
#define PG8_BAR __builtin_amdgcn_s_barrier()
#define PG8_SCHED __builtin_amdgcn_sched_barrier(0)
    Unit cur, nxt; int ui = 0;
    if (!S.next(0, cur)) return;
    typename Epi::Pre pre = E.prefetch(cur, wr, wc, fr, fq);
    f32x4 acc[2][2][4][2];
#pragma unroll
    for (int a = 0; a < 2; ++a)
#pragma unroll
        for (int b = 0; b < 2; ++b)
#pragma unroll
            for (int m = 0; m < 4; ++m)
#pragma unroll
                for (int n = 0; n < 2; ++n) acc[a][b][m][n] = (f32x4){0.f, 0.f, 0.f, 0.f};
    bf16x8 At[4][2], B0[2][2], B1[2][2];
    const char* cA = (const char*)g.A + (size_t)cur.pm * tstep; const char* cB = (const char*)g.Bt + (size_t)cur.pn * tstep;
    S.a_ready(cur);
    if constexpr (SP2) {
        PG8_STAGE(PG8_SB(0, 0), cB, voffB); PG8_STAGE(PG8_SB(0, 1), cB + hstep, voffB); PG8_STAGE(PG8_SA(0, 0), cA, voffA); PG8_STAGE(PG8_SA(0, 1), cA + hstep, voffA);
        if (wr == 1) PG8_BAR;
        PG8_WAIT_V(2); PG8_BAR;
        PG8_STAGE(PG8_SB(1, 0), cB + kstep, voffB); PG8_STAGE(PG8_SA(1, 0), cA + kstep, voffA); PG8_STAGE(PG8_SB(1, 1), cB + hstep + kstep, voffB);
        PG8_WAIT_V(6); PG8_BAR;
    } else {
        PG8_STAGE(PG8_SB(0, 0), cB, voffB); PG8_STAGE(PG8_SA(0, 0), cA, voffA); PG8_STAGE(PG8_SB(0, 1), cB + hstep, voffB); PG8_STAGE(PG8_SA(0, 1), cA + hstep, voffA);
        if (wr == 1) PG8_BAR;
        PG8_WAIT_V(4); PG8_BAR;
        PG8_STAGE(PG8_SB(1, 0), cB + kstep, voffB); PG8_STAGE(PG8_SA(1, 0), cA + kstep, voffA); PG8_STAGE(PG8_SB(1, 1), cB + hstep + kstep, voffB);
        PG8_WAIT_V(6); PG8_BAR;
    }
    for (;;) {
        const bool has_next = S.next(ui + 1, nxt);
        const char* nA = has_next ? (const char*)g.A + (size_t)nxt.pm * tstep : cA; const char* nB = has_next ? (const char*)g.Bt + (size_t)nxt.pn * tstep : cB;
        for (int t = 0; t < nt; t += 2) {
            const bool last = (t == nt - 2);
            const char* a1 = cA + (size_t)(t + 1) * kstep;
            const char* a2 = last ? nA : cA + (size_t)(t + 2) * kstep; const char* b2 = last ? nB : cB + (size_t)(t + 2) * kstep;
            const char* a3 = a2 + kstep; const char* b3 = b2 + kstep;
            if (last && has_next) S.a_ready(nxt);
            if constexpr (SP2) {
            PG8_LDB(B0, 0, 0); PG8_LDB(B1, 0, 1); PG8_SCHED; PG8_LDA(At, 0, 0); PG8_STAGE(PG8_SA(1, 1), a1 + hstep, voffA);
            PG8_WAIT_V(8); PG8_WAIT_L(0); PG8_BAR; PG8_MMA(0, 0, At, B0); PG8_MMA(0, 1, At, B1); PG8_BAR; PG8_SCHED;
            PG8_LDA(At, 0, 1); PG8_STAGE(PG8_SB(0, 0), b2, voffB); PG8_STAGE(PG8_SB(0, 1), b2 + hstep, voffB); PG8_STAGE(PG8_SA(0, 0), a2, voffA);
            PG8_WAIT_V(8); PG8_WAIT_L(0); PG8_BAR; PG8_MMA(1, 0, At, B0); PG8_MMA(1, 1, At, B1); PG8_BAR; PG8_SCHED;
            PG8_LDB(B0, 1, 0); PG8_LDB(B1, 1, 1); PG8_SCHED; PG8_LDA(At, 1, 0); PG8_STAGE(PG8_SA(0, 1), a2 + hstep, voffA);
            PG8_WAIT_V(8); PG8_WAIT_L(0); PG8_BAR; PG8_MMA(0, 0, At, B0); PG8_MMA(0, 1, At, B1); PG8_BAR; PG8_SCHED;
            PG8_LDA(At, 1, 1); PG8_STAGE(PG8_SB(1, 0), b3, voffB); PG8_STAGE(PG8_SB(1, 1), b3 + hstep, voffB); PG8_STAGE(PG8_SA(1, 0), a3, voffA);
            PG8_WAIT_V(8); PG8_WAIT_L(0); PG8_BAR; PG8_MMA(1, 0, At, B0); PG8_MMA(1, 1, At, B1); PG8_BAR; PG8_SCHED;
            } else {
            PG8_LDB(B0, 0, 0); PG8_SCHED; PG8_LDA(At, 0, 0); PG8_STAGE(PG8_SA(1, 1), a1 + hstep, voffA);
            PG8_WAIT_L(8); PG8_BAR; PG8_WAIT_L(0); PG8_MMA(0, 0, At, B0); PG8_BAR; PG8_SCHED;
            PG8_LDB(B1, 0, 1); PG8_STAGE(PG8_SB(0, 0), b2, voffB);
            PG8_BAR; PG8_WAIT_L(0); PG8_MMA(0, 1, At, B1); PG8_BAR;
            PG8_LDA(At, 0, 1); PG8_STAGE(PG8_SA(0, 0), a2, voffA);
            PG8_BAR; PG8_WAIT_L(0); PG8_MMA(1, 0, At, B0); PG8_BAR; PG8_SCHED;
            PG8_STAGE(PG8_SB(0, 1), b2 + hstep, voffB);
            PG8_WAIT_V(6); PG8_BAR; PG8_MMA(1, 1, At, B1); PG8_BAR;
            PG8_LDB(B0, 1, 0); PG8_SCHED; PG8_LDA(At, 1, 0); PG8_STAGE(PG8_SA(0, 1), a2 + hstep, voffA);
            PG8_WAIT_L(8); PG8_BAR; PG8_WAIT_L(0); PG8_MMA(0, 0, At, B0); PG8_BAR; PG8_SCHED;
            PG8_LDB(B1, 1, 1); PG8_STAGE(PG8_SB(1, 0), b3, voffB);
            PG8_BAR; PG8_WAIT_L(0); PG8_MMA(0, 1, At, B1); PG8_BAR;
            PG8_LDA(At, 1, 1); PG8_STAGE(PG8_SA(1, 0), a3, voffA);
            PG8_BAR; PG8_WAIT_L(0); PG8_MMA(1, 0, At, B0); PG8_BAR; PG8_SCHED;
            PG8_STAGE(PG8_SB(1, 1), b3 + hstep, voffB);
            PG8_WAIT_V(6); PG8_BAR; PG8_MMA(1, 1, At, B1); PG8_BAR;
            }
        }
        if constexpr (ALIGN_EPI) { if (wr == 0) PG8_BAR; }
        if constexpr (!Epi::AFTER_DRAIN) { E(acc, cur, wr, wc, fr, fq, pre); S.done(cur); }
        if (!has_next) break;
#pragma unroll
        for (int a = 0; a < 2; ++a)
#pragma unroll
            for (int b = 0; b < 2; ++b)
#pragma unroll
                for (int m = 0; m < 4; ++m)
#pragma unroll
                    for (int n = 0; n < 2; ++n) acc[a][b][m][n] = (f32x4){0.f, 0.f, 0.f, 0.f};
        cur = nxt; cA = nA; cB = nB; ++ui;
        pre = E.prefetch(cur, wr, wc, fr, fq);
        if constexpr (ALIGN_EPI) { if (wr == 1) PG8_BAR; }
    }
    PG8_WAIT_V(0);
    if constexpr (!ALIGN_EPI) { if (wr == 0) PG8_BAR; }
    PG8_BAR;
    if constexpr (Epi::AFTER_DRAIN) { E.fused(acc, cur, wr, wc, fr, fq, lds, wid, lane); S.done(cur); }
#undef PG8_SA
#undef PG8_SB
#undef PG8_STAGE
#undef PG8_LDA
#undef PG8_LDB
#undef PG8_MMA
#undef PG8_WAIT_V
#undef PG8_WAIT_L
#undef PG8_BAR
#undef PG8_SCHED
}
}

#include <hip/hip_cooperative_groups.h>
namespace cg = cooperative_groups;
#define LAS __attribute__((address_space(3)))
typedef unsigned short bf16;
typedef short bf16x8 __attribute__((ext_vector_type(8)));
typedef short s16x4 __attribute__((ext_vector_type(4)));
typedef float f32x4 __attribute__((ext_vector_type(4)));
typedef float f32x16 __attribute__((ext_vector_type(16)));
typedef unsigned u32x4 __attribute__((ext_vector_type(4)));

#define XB_TMO      128
#define XB_XCNT(j)  (256  + 64 * (j))
#define XB_XSUB(j)  (1280 + 64 * (j))
#define XB_XGEN(j)  (2304 + 64 * (j))
#define XB_TOP      3328
#define XB_TOPGEN   3392
#define XCD_BAR_WORDS 3456
#define XB_SPIN_CAP (1u << 18)

__device__ __forceinline__ unsigned xb_ld(unsigned* p)              { return __hip_atomic_load(p, __ATOMIC_RELAXED, __HIP_MEMORY_SCOPE_AGENT); }
__device__ __forceinline__ unsigned xb_add(unsigned* p, unsigned v) { return __hip_atomic_fetch_add(p, v, __ATOMIC_RELAXED, __HIP_MEMORY_SCOPE_AGENT); }
__device__ __forceinline__ unsigned xb_xcc_id() { return (unsigned)__builtin_amdgcn_s_getreg((3 << 11) | 20) & 0xFu; }
#define XB_SPIN(cond, bar) do { unsigned _sp = 0; while (cond) { __builtin_amdgcn_s_sleep(1); \
    if ((++_sp & 255u) == 0u) { if (xb_ld(&(bar)[XB_TMO])) break; if (_sp > XB_SPIN_CAP) { atomicAdd(&(bar)[XB_TMO], 1u); break; } } } } while (0)

struct XcdBarrier {
    unsigned* bar; unsigned x;
    volatile LAS unsigned* st;
};

__device__ __forceinline__ XcdBarrier xcd_barrier_post(unsigned* bar, volatile LAS unsigned* st) {
    XcdBarrier b; b.bar = bar; b.x = xb_xcc_id(); b.st = st;
    if (threadIdx.x == 0) (void)xb_add(&bar[XB_XCNT(b.x)], 1u);
    return b;
}
__device__ __forceinline__ void xcd_barrier_complete(unsigned* bar, unsigned x, unsigned& nloc, unsigned& nx) {
    const unsigned G = gridDim.x * gridDim.y * gridDim.z;
    unsigned sum, cnt, mine, sp = 0u;
    for (;;) {
        sum = 0u; cnt = 0u; mine = 0u;
#pragma unroll
        for (unsigned j = 0; j < 16; ++j) { const unsigned c = xb_ld(&bar[XB_XCNT(j)]); sum += c; cnt += (c > 0u) ? 1u : 0u; mine = (j == x) ? c : mine; }
        if (sum == G) break;
        __builtin_amdgcn_s_sleep(1);
        if ((++sp & 255u) == 0u) { if (xb_ld(&bar[XB_TMO])) break; if (sp > XB_SPIN_CAP) { atomicAdd(&bar[XB_TMO], 1u); break; } }
    }
    nloc = mine > 0u ? mine : 1u; nx = cnt > 0u ? cnt : 1u;
}

__device__ __forceinline__ void xcd_barrier(const XcdBarrier& b) {
    asm volatile("s_waitcnt vmcnt(0)" ::: "memory");
    __syncthreads();
    if (threadIdx.x == 0) {
        unsigned* bar = b.bar;
        __builtin_amdgcn_s_waitcnt(0);
        unsigned nloc = b.st[0], nx = b.st[1];
        if (nloc == 0u) { xcd_barrier_complete(bar, b.x, nloc, nx); b.st[0] = nloc; b.st[1] = nx; }
        const unsigned old = xb_add(&bar[XB_XSUB(b.x)], 1u);
        const unsigned gen = old / nloc;
        if (old + 1u == (gen + 1u) * nloc) {
            __builtin_amdgcn_fence(__ATOMIC_RELEASE, "agent");
            asm volatile("s_waitcnt vmcnt(0)" ::: "memory");
            const unsigned og = xb_add(&bar[XB_TOP], 1u);
            const unsigned tg = og / nx;
            if (og + 1u == (tg + 1u) * nx) xb_add(&bar[XB_TOPGEN], 1u);
            else XB_SPIN(xb_ld(&bar[XB_TOPGEN]) == tg, bar);
            __builtin_amdgcn_fence(__ATOMIC_ACQUIRE, "agent");
            xb_add(&bar[XB_XGEN(b.x)], 1u);
            asm volatile("s_waitcnt vmcnt(0)" ::: "memory");
        } else {
            XB_SPIN(xb_ld(&bar[XB_XGEN(b.x)]) == gen, bar);
            __builtin_amdgcn_fence(__ATOMIC_ACQUIRE, "agent");
            asm volatile("s_waitcnt vmcnt(0)" ::: "memory");
        }
    }
    __syncthreads();
}
#ifndef GEMM_ALIGN
#define GEMM_ALIGN true
#endif
#ifndef GEMM_SP2
#define GEMM_SP2 true
#endif
constexpr int BATCH = 16, SEQ = 2048, DM = 1024, M = BATCH * SEQ, NIN = 2560, FF = 4096, HD = 64, NH = 8, NG = 8, SW = 512;
constexpr size_t MiB = 1u << 20;
constexpr size_t WS_BAR = 512 * 1024, BAR_BYTES = 16384;
constexpr size_t WS_RS1 = 256 * 1024;
constexpr size_t WS_ROWSS = 0, WS_WIN = 1 * MiB, WS_WO = 6 * MiB, WS_W1 = 8 * MiB, WS_W2 = 16 * MiB, WS_WSG = 24 * MiB  , WS_HB = 32 * MiB, WS_XN = 96 * MiB, WS_SEC = 160 * MiB, WS_MIX = 320 * MiB, WS_A2 = 96 * MiB, WS_END = 384 * MiB;
constexpr size_t SEC_ELEMS = (size_t)M * SW;
constexpr int NWAVES = 8, LDS_BYTES = 155648;
constexpr int EPI_STG = 131072 + 4096;

__device__ __forceinline__ unsigned pk2(float lo, float hi) { return pg8::cvt_pk_bf16(lo, hi); }
__device__ __forceinline__ float wave_sum(float v) {
#pragma unroll
    for (int o = 1; o < 64; o <<= 1) v += __shfl_xor(v, o);
    return v;
}
__device__ __forceinline__ float bf2f(unsigned short b) { return __uint_as_float((unsigned)b << 16); }

__device__ __forceinline__ int hperm_row(int n) { const int t = n >> 8, nl = n & 255; return t * 256 + ((nl >> 5) & 1) * 128 + (nl >> 6) * 32 + (nl & 31); }
struct P0Item { const float* W; bf16* WT; const float* ksc; int K, N, r; bool hperm; };
__device__ __forceinline__ void p0_item_load(const P0Item& I, f32x4 (&wv)[8], int lane) {
    const int nblk = I.N / 32, kb = I.r / nblk, nb = I.r % nblk, k0 = 64 * kb, n0 = 32 * nb;
#pragma unroll
    for (int i = 0; i < 8; ++i) wv[i] = *(const f32x4*)(I.W + (size_t)(k0 + (lane >> 3) + 8 * i) * I.N + n0 + 4 * (lane & 7));
}
__device__ __forceinline__ void p0_item_store(const P0Item& I, const f32x4 (&wv)[8], LAS float* scr, int lane) {
    const int nblk = I.N / 32, kb = I.r / nblk, nb = I.r % nblk, k0 = 64 * kb, n0 = 32 * nb;
#pragma unroll
    for (int i = 0; i < 8; ++i) { const int kk = (lane >> 3) + 8 * i; f32x4 w = wv[i]; if (I.ksc) w = w * I.ksc[k0 + kk];
        LAS float* d = scr + kk * 33 + 4 * (lane & 7); d[0] = w[0]; d[1] = w[1]; d[2] = w[2]; d[3] = w[3]; }
    asm volatile("s_waitcnt lgkmcnt(0)" ::: "memory");
    const int c = lane & 7; const int r0 = I.hperm ? hperm_row(n0) : n0;
#pragma unroll
    for (int j = 0; j < 4; ++j) { const int n = (lane >> 3) + 8 * j; const LAS float* s = scr + (8 * c) * 33 + n;
        u32x4 o; o.x = pk2(s[0 * 33], s[1 * 33]); o.y = pk2(s[2 * 33], s[3 * 33]); o.z = pk2(s[4 * 33], s[5 * 33]); o.w = pk2(s[6 * 33], s[7 * 33]);
        *(u32x4*)(I.WT + (size_t)(r0 + n) * I.K + k0 + 8 * c) = o; }
    asm volatile("s_waitcnt lgkmcnt(0)" ::: "memory");
}
struct Ptrs {
    const float *x, *g1, *win, *gq, *gk, *gvs, *sgw, *sgb, *gsb, *gsg, *wout, *g2, *w1, *w2;
    float* out; unsigned char* ws;
};
__device__ __forceinline__ void p0_prologue(const Ptrs& P, LAS unsigned char* lds, int vcu, int G, int wave, int lane) {
    LAS float* scr = (LAS float*)(lds + wave * 16384);
    const int gw = vcu * NWAVES + wave, NGW = G * NWAVES;
    constexpr int I_IN = (DM / 64) * (NIN / 32), I_O = (DM / 64) * (DM / 32), I_1 = (DM / 64) * (FF / 32), I_2 = (FF / 64) * (DM / 32);
    constexpr int NITEMS = I_IN + I_O + I_1 + I_2;
    bf16* Win_t = (bf16*)(P.ws + WS_WIN); bf16* Wo_t = (bf16*)(P.ws + WS_WO); bf16* W1_t = (bf16*)(P.ws + WS_W1); bf16* W2_t = (bf16*)(P.ws + WS_W2);
#define P0_DECODE(I, it_) do { int r_ = (it_); \
        if (r_ < I_IN) { I.W = P.win; I.WT = Win_t; I.ksc = P.g1; I.K = DM; I.N = NIN; I.hperm = true; } \
        else if ((r_ -= I_IN) < I_O) { I.W = P.wout; I.WT = Wo_t; I.ksc = nullptr; I.K = DM; I.N = DM; I.hperm = true; } \
        else if ((r_ -= I_O) < I_1) { I.W = P.w1; I.WT = W1_t; I.ksc = P.g2; I.K = DM; I.N = FF; I.hperm = true; } \
        else { r_ -= I_1; I.W = P.w2; I.WT = W2_t; I.ksc = nullptr; I.K = FF; I.N = DM; I.hperm = false; } \
        I.r = r_; } while (0)

    if (gw < NITEMS) {
        P0Item C, Nx; f32x4 wv[8], wn[8];
        P0_DECODE(C, gw); p0_item_load(C, wv, lane);
        for (int it = gw; it < NITEMS; it += NGW) {
            const bool more = it + NGW < NITEMS;
            if (more) { P0_DECODE(Nx, it + NGW); p0_item_load(Nx, wn, lane); }
            p0_item_store(C, wv, scr, lane);
            if (more) { C = Nx;
#pragma unroll
                for (int i = 0; i < 8; ++i) wv[i] = wn[i]; }
        }
    }
#undef P0_DECODE

    for (int it = gw; it < 256; it += NGW) { const int idx = it * 512 + lane * 8, t = (idx >> 7) & 127, s0 = idx & 127;
        const f32x4 a = *(const f32x4*)(P.sgw + idx), c4 = *(const f32x4*)(P.sgw + idx + 4);
        float w[8] = {a[0], a[1], a[2], a[3], c4[0], c4[1], c4[2], c4[3]};
#pragma unroll
        for (int j = 0; j < 8; ++j) if (s0 + j > t) w[j] = 0.f;
        *(u32x4*)((bf16*)(P.ws + WS_WSG) + idx) = (u32x4){pk2(w[0], w[1]), pk2(w[2], w[3]), pk2(w[4], w[5]), pk2(w[6], w[7])}; }

    bf16* XN = (bf16*)(P.ws + WS_XN); float* rowss = (float*)(P.ws + WS_ROWSS); float* rs1 = (float*)(P.ws + WS_RS1);
    f32x4 gv[4];
#pragma unroll
    for (int j = 0; j < 4; ++j) gv[j] = ((const f32x4*)P.g1)[lane + 64 * j];
    for (int m0 = 8 * gw; m0 < M; m0 += 8 * NGW) {
        f32x4 v[8][4];
#pragma unroll
        for (int i = 0; i < 8; ++i) { const f32x4* xr = (const f32x4*)(P.x + (size_t)(m0 + i) * DM) + lane;
#pragma unroll
            for (int j = 0; j < 4; ++j) v[i][j] = xr[64 * j]; }
#pragma unroll
        for (int i = 0; i < 8; ++i) { const int m = m0 + i; float s = 0.f;
#pragma unroll
            for (int j = 0; j < 4; ++j) s += (v[i][j].x * v[i][j].x + v[i][j].y * v[i][j].y) + (v[i][j].z * v[i][j].z + v[i][j].w * v[i][j].w);
            const float rs = __builtin_amdgcn_rsqf(wave_sum(s) * (1.f / DM) + 1e-6f);
            unsigned long long* o8 = (unsigned long long*)(XN + (size_t)m * DM) + lane;
#pragma unroll
            for (int j = 0; j < 4; ++j) { const f32x4 t = v[i][j]; o8[64 * j] = (unsigned long long)pk2(t.x, t.y) | ((unsigned long long)pk2(t.z, t.w) << 32); }
            if (lane == 0) { rowss[m] = 0.f; rs1[m] = rs; } }
    }

}

constexpr int AT_K = 0, AT_V = 16384, AT_STG = 32768, AT_STG_W = 32 * 68 * 4;
__device__ __forceinline__ int crow(int r, int hi) { return (r & 3) + 8 * (r >> 2) + 4 * hi; }
__device__ __forceinline__ s16x4 vtr(const LAS char* p) { typedef short v4i16_t __attribute__((ext_vector_type(4))); return __builtin_bit_cast(s16x4, __builtin_amdgcn_ds_read_tr16_b64_v4i16((LAS v4i16_t*)p)); }

template <bool MASK>
__device__ __forceinline__ void attn_scores(f32x16& p0, f32x16& p1, float& Racc, int dq  , int hi, u32x4 (&pw)[4]) {
    f32x16 s0, s1;
#pragma unroll
    for (int r = 0; r < 16; ++r) {
        float a = __builtin_amdgcn_logf(1.0f + __builtin_amdgcn_exp2f(p0[r])), b = __builtin_amdgcn_logf(1.0f + __builtin_amdgcn_exp2f(p1[r]));
        if (MASK) { const int kr = (r & 3) + 8 * (r >> 2); if (!(kr < dq)) a = 0.f; if (!(kr + 32 < dq)) b = 0.f; }
        s0[r] = a; s1[r] = b;
    }
#pragma unroll
    for (int g = 0; g < 4; ++g) {
        s0[4 * g + 2] += s0[4 * g + 3]; s0[4 * g + 1] += s0[4 * g + 2]; s0[4 * g] += s0[4 * g + 1];
        s1[4 * g + 2] += s1[4 * g + 3]; s1[4 * g + 1] += s1[4 * g + 2]; s1[4 * g] += s1[4 * g + 1];
    }
    float g1v[8], H[8];
#pragma unroll
    for (int i = 0; i < 8; ++i) {
        const float t = i < 4 ? s0[4 * i] : s1[4 * (i - 4)];
        auto rr = __builtin_amdgcn_permlane32_swap(__float_as_uint(t), __float_as_uint(t), false, false);
        const float lo = __uint_as_float(rr[0]), hh = __uint_as_float(rr[1]);
        g1v[i] = hh; H[i] = lo + hh;
    }
    float off[8]; float sfx = 0.f;
#pragma unroll
    for (int i = 7; i >= 0; --i) { off[i] = sfx + Racc + (hi == 0 ? g1v[i] : 0.f); sfx += H[i]; }
    Racc += sfx;
#pragma unroll
    for (int r = 0; r < 16; ++r) {
        float a = __builtin_amdgcn_exp2f(p0[r] - (s0[r] + off[r >> 2])), b = __builtin_amdgcn_exp2f(p1[r] - (s1[r] + off[4 + (r >> 2)]));
        if (MASK) { const int kr = (r & 3) + 8 * (r >> 2); if (!(kr < dq)) a = 0.f; if (!(kr + 32 < dq)) b = 0.f; }
        p0[r] = a; p1[r] = b;
    }
#pragma unroll
    for (int ks = 0; ks < 4; ++ks) {
        const int b8 = 8 * (ks & 1);
        if (ks < 2) pw[ks] = (u32x4){pk2(p0[b8], p0[b8 + 1]), pk2(p0[b8 + 2], p0[b8 + 3]), pk2(p0[b8 + 4], p0[b8 + 5]), pk2(p0[b8 + 6], p0[b8 + 7])};
        else        pw[ks] = (u32x4){pk2(p1[b8], p1[b8 + 1]), pk2(p1[b8 + 2], p1[b8 + 3]), pk2(p1[b8 + 4], p1[b8 + 5]), pk2(p1[b8 + 6], p1[b8 + 7])};
    }
}
__device__ __forceinline__ void attn_pv(f32x16 (&o)[2], const u32x4 (&pw)[4], const LAS char* vp) {
#pragma unroll
    for (int ks = 0; ks < 4; ++ks)
#pragma unroll
        for (int d0 = 0; d0 < 2; ++d0) {
            const s16x4 lo = vtr(vp + d0 * 4096 + ks * 1024), hh = vtr(vp + d0 * 4096 + ks * 1024 + 512);
            const bf16x8 vf = (bf16x8){lo[0], lo[1], lo[2], lo[3], hh[0], hh[1], hh[2], hh[3]};
            o[d0] = __builtin_amdgcn_mfma_f32_32x32x16_bf16(vf, __builtin_bit_cast(bf16x8, pw[ks]), o[d0], 0, 0, 0);
        }
}
__device__ __forceinline__ void glds16(const void* gsrc, unsigned lds_dst) { unsigned keep;
    asm volatile("s_mov_b32 %0, m0\n\ts_mov_b32 m0, %2\n\ts_nop 0\n\tglobal_load_lds_dwordx4 %1, off\n\ts_mov_b32 m0, %0" : "=&s"(keep) : "v"(gsrc), "s"(lds_dst) : "memory"); }
#ifndef ATTN_EXIT_THR
#define ATTN_EXIT_THR 150.0f
#endif
__device__ __forceinline__ void attn_wave(int b, int h, int rb, const bf16* Q, const bf16* K, const bf16* V, bf16* MIX, const float* gout, LAS char* wl) {

    const int lane = threadIdx.x & 63, r32 = lane & 31, hi = lane >> 5;
    const size_t rowbase = (size_t)b * SEQ; const int qw0 = rb * 32;
    const bf16* Qw = Q + (rowbase + qw0) * SW + h * HD;
    const bf16* ksrc = K + (rowbase + (lane >> 3)) * SW + h * HD;
    const int kch0 = ((lane & 7) ^ (lane >> 4)) * 8, kch1 = ((lane & 7) ^ (4 + (lane >> 4))) * 8;
    const bf16* vsrc = V + (rowbase + (lane >> 2)) * SW + h * HD + (lane & 3) * 8;
    const LAS char* kp0 = wl + r32 * 128; const int ksw = (r32 >> 1) & 7;
    const LAS char* vp0 = wl + 8192 + ((lane >> 4) & 1) * 32 + (lane & 3) * 8 + (4 * hi + ((lane & 15) >> 2)) * 64;
    const int NTw = (qw0 + 30) / 64 + 1;
    bf16x8 qr[4];
#pragma unroll
    for (int d0 = 0; d0 < 4; ++d0) qr[d0] = *(const bf16x8*)(Qw + (size_t)r32 * SW + d0 * 16 + hi * 8);
    const unsigned kdma = (unsigned)__builtin_amdgcn_readfirstlane((int)(unsigned)(uintptr_t)wl), vdma = kdma + 8192u;
#define AT_DMAK(t) do { const bf16* kq_ = ksrc + (size_t)(t) * 64 * SW; _Pragma("unroll") for (int c_ = 0; c_ < 8; ++c_) glds16(kq_ + (size_t)(8 * c_) * SW + ((c_ & 1) ? kch1 : kch0), kdma + c_ * 1024); } while (0)
#define AT_DMAV(t) do { const bf16* vq_ = vsrc + (size_t)(t) * 64 * SW; _Pragma("unroll") for (int c_ = 0; c_ < 8; ++c_) glds16(vq_ + (size_t)(16 * (c_ & 3)) * SW + (c_ >> 2) * 32, vdma + c_ * 1024); } while (0)
#define AT_QK(P0, P1) do { _Pragma("unroll") for (int d0 = 0; d0 < 4; ++d0) { const LAS char* kq = kp0 + (((2 * d0 + hi) ^ ksw) * 16); \
        const bf16x8 b0 = *(const LAS bf16x8*)kq, b1 = *(const LAS bf16x8*)(kq + 4096); \
        P0 = __builtin_amdgcn_mfma_f32_32x32x16_bf16(b0, qr[d0], P0, 0, 0, 0); P1 = __builtin_amdgcn_mfma_f32_32x32x16_bf16(b1, qr[d0], P1, 0, 0, 0); } } while (0)
    asm volatile("s_waitcnt lgkmcnt(0)" ::: "memory");
    AT_DMAK(NTw - 1);
    f32x16 o[2]; o[0] = (f32x16){}; o[1] = (f32x16){};
    float Racc = 0.f;
    f32x16 p0 = (f32x16){}, p1 = (f32x16){};
    asm volatile("s_waitcnt vmcnt(0)" ::: "memory");
    AT_QK(p0, p1);
    asm volatile("s_waitcnt lgkmcnt(0)" ::: "memory");
    if (NTw >= 2) AT_DMAK(NTw - 2);

    u32x4 pw[4];
    int t = NTw - 1;
    for (;; --t) {
        asm volatile("s_waitcnt vmcnt(0)" ::: "memory");
        if (t < NTw - 1) attn_pv(o, pw, vp0);
        f32x16 n0 = (f32x16){}, n1 = (f32x16){};
        if (t > 0) AT_QK(n0, n1);
        asm volatile("s_waitcnt lgkmcnt(0)" ::: "memory");
        AT_DMAV(t);
        if (t >= 2) AT_DMAK(t - 2);
        __builtin_amdgcn_sched_barrier(0);
        const int kv0 = 64 * t, dq = qw0 + r32 - kv0 - 4 * hi;
        if (kv0 + 64 <= qw0) attn_scores<false>(p0, p1, Racc, dq, hi, pw);
        else                 attn_scores<true>(p0, p1, Racc, dq, hi, pw);
        if (__all(Racc > ATTN_EXIT_THR) || t == 0) break;
        p0 = n0; p1 = n1;
    }

    asm volatile("s_waitcnt vmcnt(0)" ::: "memory");
    attn_pv(o, pw, vp0);
#undef AT_DMAK
#undef AT_DMAV
#undef AT_QK
    float ss = 0.f;
#pragma unroll
    for (int r = 0; r < 16; ++r) ss += o[0][r] * o[0][r] + o[1][r] * o[1][r];
    { auto rr = __builtin_amdgcn_permlane32_swap(__float_as_uint(ss), __float_as_uint(ss), false, false); ss = __uint_as_float(rr[0]) + __uint_as_float(rr[1]); }
    const float rs = __builtin_amdgcn_rsqf(ss * (1.f / 64.f) + 1e-6f);
    f32x4 gg[2][4];
#pragma unroll
    for (int d0 = 0; d0 < 2; ++d0)
#pragma unroll
        for (int g4 = 0; g4 < 4; ++g4) gg[d0][g4] = *(const f32x4*)(gout + 32 * d0 + 8 * g4 + 4 * hi);
    asm volatile("s_waitcnt lgkmcnt(0)" ::: "memory");
    typedef unsigned u32x2_t __attribute__((ext_vector_type(2)));
#pragma unroll
    for (int d0 = 0; d0 < 2; ++d0)
#pragma unroll
        for (int g4 = 0; g4 < 4; ++g4) {
            u32x2_t w; w.x = pk2(o[d0][4 * g4] * rs * gg[d0][g4][0], o[d0][4 * g4 + 1] * rs * gg[d0][g4][1]); w.y = pk2(o[d0][4 * g4 + 2] * rs * gg[d0][g4][2], o[d0][4 * g4 + 3] * rs * gg[d0][g4][3]);
            *(LAS u32x2_t*)(wl + r32 * 128 + (((4 * d0 + g4) ^ (r32 & 7)) * 16) + 8 * hi) = w;
        }
    asm volatile("s_waitcnt lgkmcnt(0)" ::: "memory");
    bf16* obase = MIX + (rowbase + qw0) * DM + h * HD;
#pragma unroll
    for (int i = 0; i < 4; ++i) { const int row = i * 8 + (lane >> 3), ch = lane & 7;
        const u32x4 v = *(const LAS u32x4*)(wl + row * 128 + ((ch ^ (row & 7)) * 16));
        *(u32x4*)(obase + (size_t)row * DM + ch * 8) = v; }
    asm volatile("s_waitcnt lgkmcnt(0)" ::: "memory");
}

constexpr int SG_VN = 0, SG_VNB = 16384, SG_STG = 32768;
struct SgPre { bf16x8 wf[8]; u32x4 u0, u1; float bias; };
__device__ __forceinline__ void sg_prefetch(SgPre& R, int item, const bf16* VS, const bf16* U, const bf16* wsg, const float* sgb, unsigned vn_lds, int wid, int lane, bool do_w) {
    const int g = item & 7, c = (item >> 3) & 15, b = item >> 7, tid = wid * 64 + lane;
    const size_t row0 = (size_t)b * SEQ + 128 * c;
#pragma unroll
    for (int i = 0; i < 2; ++i) { const int p = 2 * wid + i, dh = p >> 3, q = p & 7;
        glds16(VS + (row0 + 16 * q + (lane >> 2)) * SW + 64 * g + dh * 32 + (lane & 3) * 8, vn_lds + p * 1024); }
    const int r32 = lane & 31, hi = lane >> 5, tb = wid >> 1, t = 32 * tb + r32;
    const bf16* wrow = wsg + ((size_t)g * 128 + t) * 128 + 8 * hi;
    const int row = tid >> 2, part = tid & 3;
    if (do_w) {
#pragma unroll
        for (int ks = 0; ks < 8; ++ks) R.wf[ks] = *(const bf16x8*)(wrow + 16 * ks);
        R.bias = sgb[g * 128 + row];
    }
    R.u0 = *(const u32x4*)(U + (row0 + row) * SW + 64 * g + part * 16); R.u1 = *(const u32x4*)(U + (row0 + row) * SW + 64 * g + part * 16 + 8);
}
__device__ __forceinline__ void sg_phase(int first, int stride, int n_items, const bf16* VS, const bf16* U, const bf16* wsg, const float* sgb, const float* gout, bf16* MIX, LAS char* shm) {
    const int tid = threadIdx.x, lane = tid & 63, r32 = lane & 31, hi = lane >> 5; const int wid = __builtin_amdgcn_readfirstlane(tid >> 6);
    const unsigned lds0 = (unsigned)__builtin_amdgcn_readfirstlane((int)(unsigned)(uintptr_t)shm);
    const int tb = wid >> 1, dh = wid & 1, nks = 2 * tb + 2;
    const int row = tid >> 2, part = tid & 3;
    if (first >= n_items) return;
    f32x4 gg[4];
#pragma unroll
    for (int q = 0; q < 4; ++q) gg[q] = *(const f32x4*)(gout + part * 16 + 4 * q);
    SgPre N;
    const bool same_g = (stride & 7) == 0;
    sg_prefetch(N, first, VS, U, wsg, sgb, lds0 + SG_VN, wid, lane, true);
    int k = 0;
    for (int item = first; item < n_items; item += stride, ++k) {
        const SgPre C = N;
        asm volatile("s_waitcnt vmcnt(2)" ::: "memory");
        __syncthreads();
        const int buf = (k & 1) * 16384;
        if (item + stride < n_items) sg_prefetch(N, item + stride, VS, U, wsg, sgb, lds0 + (buf ^ 16384), wid, lane, !same_g);
        const int g = item & 7, c = (item >> 3) & 15, b = item >> 7;
        const size_t row0 = (size_t)b * SEQ + 128 * c;
        f32x16 acc = (f32x16){};
        const LAS char* vp = shm + buf + dh * 8192 + (8 * hi + ((lane & 15) >> 2)) * 64 + ((lane >> 4) & 1) * 32 + (lane & 3) * 8;
#pragma unroll
        for (int ks = 0; ks < 8; ++ks) {
            if (ks < nks) {
                const s16x4 lo = vtr(vp + ks * 1024), hh = vtr(vp + ks * 1024 + 256);
                const bf16x8 vf = (bf16x8){lo[0], lo[1], lo[2], lo[3], hh[0], hh[1], hh[2], hh[3]};
                acc = __builtin_amdgcn_mfma_f32_32x32x16_bf16(C.wf[ks], vf, acc, 0, 0, 0);
            }
        }
        LAS float* stg = (LAS float*)(shm + SG_STG);
#pragma unroll
        for (int r = 0; r < 16; ++r) stg[(32 * tb + crow(r, hi)) * 68 + 32 * dh + r32] = acc[r];
        __syncthreads();
        float val[16]; float s = 0.f;
#pragma unroll
        for (int q = 0; q < 4; ++q) {
            const f32x4 y = *(const LAS f32x4*)(stg + row * 68 + part * 16 + 4 * q);
            const unsigned ua = q < 2 ? C.u0[2 * (q & 1)] : C.u1[2 * (q & 1)], ub = q < 2 ? C.u0[2 * (q & 1) + 1] : C.u1[2 * (q & 1) + 1];
            val[4 * q + 0] = __uint_as_float(ua << 16) * (y[0] + C.bias); val[4 * q + 1] = __uint_as_float(ua & 0xffff0000u) * (y[1] + C.bias);
            val[4 * q + 2] = __uint_as_float(ub << 16) * (y[2] + C.bias); val[4 * q + 3] = __uint_as_float(ub & 0xffff0000u) * (y[3] + C.bias);
        }
#pragma unroll
        for (int e = 0; e < 16; ++e) s += val[e] * val[e];
        s += __shfl_xor(s, 1); s += __shfl_xor(s, 2);
        const float rs = __builtin_amdgcn_rsqf(s * (1.f / 64.f) + 1e-6f);
        u32x4 w0, w1;
#pragma unroll
        for (int q = 0; q < 4; ++q) {
            const unsigned lo = pk2(val[4 * q] * rs * gg[q][0], val[4 * q + 1] * rs * gg[q][1]), hh = pk2(val[4 * q + 2] * rs * gg[q][2], val[4 * q + 3] * rs * gg[q][3]);
            if (q < 2) { w0[2 * q] = lo; w0[2 * q + 1] = hh; } else { w1[2 * (q - 2)] = lo; w1[2 * (q - 2) + 1] = hh; }
        }
        bf16* op = MIX + (row0 + row) * DM + 512 + 64 * g + part * 16;
        *(u32x4*)op = w0; *(u32x4*)(op + 8) = w1;
    }
}

struct Args { Ptrs p; int ph_lo, ph_hi; };
__global__ void __launch_bounds__(NWAVES * 64, 2) mega_fwd(Args args) {
    extern __shared__ __attribute__((aligned(16))) unsigned char lds_raw[];
    cg::grid_group grid = cg::this_grid();
    LAS unsigned char* lds = (LAS unsigned char*)lds_raw;
    const Ptrs& P = args.p;
    const int tid = threadIdx.x, lane = tid & 63, wave = __builtin_amdgcn_readfirstlane(tid >> 6);
    const int G = gridDim.x, bx = blockIdx.x, vcu = (G % 8 == 0) ? (bx % 8) * (G / 8) + bx / 8 : bx;
    const int lo = args.ph_lo, hi = args.ph_hi;
    unsigned char* ws = P.ws;
    bf16* SEC = (bf16*)(ws + WS_SEC); bf16* MIX = (bf16*)(ws + WS_MIX); bf16* HB = (bf16*)(ws + WS_HB); bf16* XN = (bf16*)(ws + WS_XN); bf16* A2 = (bf16*)(ws + WS_A2);
    float* rowss = (float*)(ws + WS_ROWSS);
    volatile LAS unsigned* MISC = (volatile LAS unsigned*)(lds + 131072 + 320);
    if (tid < 32) MISC[tid] = 0u;
    __syncthreads();
    const XcdBarrier bar = xcd_barrier_post((unsigned*)(ws + WS_BAR), MISC + 8);
    if (lo < 0) grid.sync();
#define IN(k) (lo <= (k) && (k) < hi)
#define SEAM(k) do { if (IN(k) && IN((k) + 1)) xcd_barrier(bar); } while (0)
    if (IN(0)) p0_prologue(P, lds, vcu, G, wave, lane);
    SEAM(0);

    if (IN(1)) {
        pg8::Gemm g{XN, (const bf16*)(ws + WS_WIN), M, NIN, DM}; pg8::StaticOrder S; S.init(M, NIN, G, bx);
        pg8::EpiProj E{SEC, SEC_ELEMS, P.gq, P.gk, P.gvs, (const float*)(ws + WS_RS1), lds + EPI_STG};
        pg8::gemm_phase<pg8::EpiProj, pg8::StaticOrder, GEMM_ALIGN, GEMM_SP2>(lds, g, S, E);
    }
    SEAM(1);

    if (IN(2)) {
        const bf16 *Qs = SEC, *Ks = SEC + SEC_ELEMS, *Vs = SEC + 2 * SEC_ELEMS, *Us = SEC + 3 * SEC_ELEMS, *VSs = SEC + 4 * SEC_ELEMS;
        for (int pid = vcu * NWAVES + wave; pid < BATCH * NH * 32; pid += G * NWAVES) {
            const int bh = pid >> 5, j = pid & 31;
            attn_wave(bh / NH, bh % NH, 63 - j, Qs, Ks, Vs, MIX, P.gsb, (LAS char*)lds + wave * 16384);
            attn_wave(bh / NH, bh % NH, j, Qs, Ks, Vs, MIX, P.gsb, (LAS char*)lds + wave * 16384);
        }
        __syncthreads();
        sg_phase(vcu, G, BATCH * 16 * NG, VSs, Us, (const bf16*)(ws + WS_WSG), P.sgb, P.gsg, MIX, (LAS char*)lds);
        __syncthreads();
    }
    SEAM(2);

    if (IN(3)) {
        pg8::Gemm g{MIX, (const bf16*)(ws + WS_WO), M, DM, DM}; pg8::StaticOrder S; S.init(M, DM, G, bx);
        pg8::EpiOut E{XN, HB, rowss, lds + EPI_STG};
        pg8::gemm_phase<pg8::EpiOut, pg8::StaticOrder, GEMM_ALIGN, GEMM_SP2>(lds, g, S, E);
    }
    SEAM(3);

    if (IN(4)) {
        pg8::Gemm g{HB, (const bf16*)(ws + WS_W1), M, FF, DM}; pg8::StaticOrder S; S.init(M, FF, G, bx);
        pg8::EpiFF1 E{A2, rowss, lds + EPI_STG};
        pg8::gemm_phase<pg8::EpiFF1, pg8::StaticOrder, GEMM_ALIGN, GEMM_SP2>(lds, g, S, E);
    }
    SEAM(4);

    if (IN(5)) {
        pg8::Gemm g{A2, (const bf16*)(ws + WS_W2), M, DM, FF}; pg8::StaticOrder S; S.init(M, DM, G, bx);
        pg8::EpiFF2 E{P.out, HB, lds + EPI_STG};
        pg8::gemm_phase<pg8::EpiFF2, pg8::StaticOrder, GEMM_ALIGN, GEMM_SP2>(lds, g, S, E);
    }
#undef IN
#undef SEAM
}

extern "C" void kernel_launch(void* const* d_in, const int* in_sizes, int n_in, void* d_out, int out_size, void* d_ws, size_t ws_size, hipStream_t stream) {
    static int grid = 0;
    if (grid == 0) {
        if (n_in != 14 || in_sizes[0] != M * DM || out_size != M * DM || ws_size < WS_END) { fprintf(stderr, "kernel_launch: unexpected shapes / workspace (n_in %d, ws %zu)\n", n_in, ws_size); grid = -1; return; }
        int dev = 0, cus = 0, per_cu = 0;
        hipGetDevice(&dev); hipDeviceGetAttribute(&cus, hipDeviceAttributeMultiprocessorCount, dev);
        hipFuncSetAttribute((const void*)mega_fwd, hipFuncAttributeMaxDynamicSharedMemorySize, LDS_BYTES);
        hipOccupancyMaxActiveBlocksPerMultiprocessor(&per_cu, (const void*)mega_fwd, NWAVES * 64, LDS_BYTES);
        if (per_cu < 1) { fprintf(stderr, "kernel_launch: occupancy query says %d blocks per CU\n", per_cu); per_cu = 1; }
        (void)hipGetLastError();
        grid = cus;
        if (M % (8 * grid * NWAVES) != 0) { fprintf(stderr, "kernel_launch: %d CUs: the prologue's row loop needs M %% (64 * CUs) == 0; nothing launched\n", cus); grid = -1; return; }
    }
    if (grid < 0) return;
    Args a{};
    const float** pp = (const float**)&a.p;
    for (int i = 0; i < 14; ++i) pp[i] = (const float*)d_in[i];
    a.p.out = (float*)d_out; a.p.ws = (unsigned char*)d_ws;
#ifndef PH_RANGES
#define PH_RANGES {0, 6}
#endif
    const int rng[] = PH_RANGES;
    for (int li = 0; li < (int)(sizeof(rng) / sizeof(int)) / 2; ++li) {
        a.ph_lo = rng[2 * li]; a.ph_hi = rng[2 * li + 1];
        if (hipMemsetAsync((char*)d_ws + WS_BAR, 0, BAR_BYTES, stream) != hipSuccess) { fprintf(stderr, "kernel_launch: memset failed\n"); break; }
        void* kargs[] = {&a};
        hipError_t e = hipLaunchCooperativeKernel((const void*)mega_fwd, dim3(grid), dim3(NWAVES * 64), kargs, LDS_BYTES, stream);
        if (e != hipSuccess) { fprintf(stderr, "kernel_launch: cooperative launch failed: %s\n", hipGetErrorString(e)); break; }
    }
}
```

```cpp
#include <hip/hip_runtime.h>
#include <cstdio>
#include <cstdint>
#define P5_ALIGN false
#ifndef PG8_RELAX
#define PG8_RELAX true
#endif
namespace pg8 {
#define PG8_LAS __attribute__((address_space(3)))
typedef unsigned short bf16_t;
typedef short bf16x8 __attribute__((ext_vector_type(8)));
typedef float f32x4 __attribute__((ext_vector_type(4)));
typedef unsigned u32x4 __attribute__((ext_vector_type(4)));
constexpr int BM = 256, BK = 64, HALF = 128, HTB = HALF * BK * 2  , STAGE_BYTES = 8 * HTB, NXCD = 8, WGM = 8;

__host__ __device__ __forceinline__ int lds_byte(int r, int c) { const int st = (r >> 4) * 2 + (c >> 5), rr = r & 15, cc = c & 31, ob = rr * 64 + cc * 2; return st * 1024 + (ob ^ (((ob >> 9) & 1) << 5)); }
__host__ __device__ __forceinline__ void stage_rc(int b, int& R, int& C) { const int st = b / 1024, sb = b % 1024, swz = sb ^ (((sb >> 9) & 1) << 5); R = (st >> 1) * 16 + swz / 64; C = (st & 1) * 32 + (swz % 64) / 2; }
__host__ __device__ __forceinline__ int perm32(int rho) { const int n = rho >> 4, i = rho & 15; return 8 * (i >> 2) + 4 * n + (i & 3); }

struct Unit { int pm, pn; };
struct Gemm { const bf16_t* A; const bf16_t* Bt; int M, N, K; };

struct StaticOrder {
    int nM, nN, nwg, G, c;
    __host__ __device__ void init(int M, int N, int G_, int c_) { nM = M / BM; nN = N / BM; nwg = nM * nN; G = G_; c = c_; }
    __host__ __device__ bool next(int i, Unit& u) const {
        const long L = (long)i * G + c; if (L >= nwg) return false;
        int wgid = (int)L; { const int q = nwg / NXCD, r = nwg % NXCD, xcd = wgid % NXCD, off = wgid / NXCD; wgid = (xcd < r ? xcd * (q + 1) : r * (q + 1) + (xcd - r) * q) + off; }
        const int nig = WGM * nN, gid = wgid / nig, fm = gid * WGM, gsz = (nM - fm) < WGM ? (nM - fm) : WGM;
        u.pm = fm + ((wgid % nig) % gsz); u.pn = (wgid % nig) / gsz; return true;
    }
    __device__ __forceinline__ void a_ready(const Unit&) const {}
    __device__ __forceinline__ void done(const Unit&) const {}
};

__device__ __forceinline__ unsigned cvt_pk_bf16(float lo, float hi) { unsigned r; asm volatile("v_cvt_pk_bf16_f32 %0, %1, %2" : "=v"(r) : "v"(lo), "v"(hi)); return r; }
typedef float f32x2 __attribute__((ext_vector_type(2)));
typedef float f32x2 __attribute__((ext_vector_type(2)));
typedef unsigned u32x2 __attribute__((ext_vector_type(2)));

__device__ __forceinline__ void stage_store16(PG8_LAS unsigned char* stg, bf16_t* row0p  , size_t pitch  , int fr, int c0, int c1  , const u32x4& w0, const u32x4& w1) {
    const int lane = threadIdx.x & 63;
    *(PG8_LAS u32x4*)(stg + fr * 128 + ((c0 ^ (fr & 7)) * 16)) = w0;
    *(PG8_LAS u32x4*)(stg + fr * 128 + ((c1 ^ (fr & 7)) * 16)) = w1;
    asm volatile("" ::: "memory");
#pragma unroll
    for (int i = 0; i < 2; ++i) { const int row = i * 8 + (lane >> 3), ch = lane & 7;
        const u32x4 v = *(const PG8_LAS u32x4*)(stg + row * 128 + ((ch ^ (row & 7)) * 16));
        *(u32x4*)(row0p + (size_t)row * pitch + ch * 8) = v; }
    asm volatile("" ::: "memory");
}
struct EpiProj {
    static constexpr bool PERM = true, AFTER_DRAIN = false; static constexpr int NSTORE = 16;
    bf16_t* base; size_t sec_stride; const float* gq; const float* gk; const float* gvs; const float* rs1; PG8_LAS unsigned char* stg;
    __device__ __forceinline__ void operator()(const f32x4 (&acc)[2][2][4][2], const Unit& u, int wr, int wc, int fr, int fq) const {
        const int sec = u.pn >> 1;
        bf16_t* O = base + (size_t)sec * sec_stride;
        const int col0 = (u.pn & 1) * 256 + wc * 64 + 8 * fq;
        const float *ga = gq, *gb = gk, *gc = gvs;
        asm volatile("" : "+s"(ga), "+s"(gb), "+s"(gc));
        const float* g = sec == 0 ? ga : (sec == 1 ? gb : gc);
        const bool nrm = (sec == 0) || (sec == 1) || (sec == 4);
        const float post = sec == 0 ? 0.18033688011112042f : 1.0f;
        f32x4 gv[2][2];
#pragma unroll
        for (int bj = 0; bj < 2; ++bj)
#pragma unroll
            for (int n = 0; n < 2; ++n) gv[bj][n] = nrm ? *(const f32x4*)(g + 32 * bj + 8 * fq + 4 * n) * post : (f32x4){1.f, 1.f, 1.f, 1.f};
        float r1v[2][4];
#pragma unroll
        for (int ai = 0; ai < 2; ++ai)
#pragma unroll
            for (int m = 0; m < 4; ++m) r1v[ai][m] = rs1[u.pm * BM + ai * HALF + wr * 64 + m * 16 + fr];
#pragma unroll
        for (int ai = 0; ai < 2; ++ai)
#pragma unroll
            for (int m = 0; m < 4; ++m) {
                const float r1 = r1v[ai][m]; float rs = r1;
                if (nrm) {
                    float s = 0.f;
#pragma unroll
                    for (int bj = 0; bj < 2; ++bj)
#pragma unroll
                        for (int n = 0; n < 2; ++n) { const f32x4 x = acc[ai][bj][m][n]; s += (x[0] * x[0] + x[1] * x[1]) + (x[2] * x[2] + x[3] * x[3]); }
                    s += __shfl_xor(s, 16); s += __shfl_xor(s, 32);
                    rs = __builtin_amdgcn_rsqf(s * (r1 * r1) * (1.0f / 64.0f) + 1e-6f) * r1;
                }
                u32x4 w[2];
#pragma unroll
                for (int bj = 0; bj < 2; ++bj) {
                    const f32x4 v0 = acc[ai][bj][m][0] * rs * gv[bj][0], v1 = acc[ai][bj][m][1] * rs * gv[bj][1];
                    w[bj].x = cvt_pk_bf16(v0[0], v0[1]); w[bj].y = cvt_pk_bf16(v0[2], v0[3]); w[bj].z = cvt_pk_bf16(v1[0], v1[1]); w[bj].w = cvt_pk_bf16(v1[2], v1[3]);
                }
                stage_store16(stg + (wr * 4 + wc) * 2048, O + (size_t)(u.pm * BM + ai * HALF + wr * 64 + m * 16) * 512 + (u.pn & 1) * 256 + wc * 64, 512, fr, fq, 4 + fq, w[0], w[1]);
            }
    }
};

struct EpiOut {
    static constexpr bool PERM = true, AFTER_DRAIN = false; static constexpr int NSTORE = 16;
    const bf16_t* xb; bf16_t* hb; float* rowss; PG8_LAS unsigned char* stg;
    __device__ __forceinline__ void operator()(const f32x4 (&acc)[2][2][4][2], const Unit& u, int wr, int wc, int fr, int fq) const {
        const int col0 = u.pn * BM + wc * 64 + 8 * fq;
        u32x4 xv[2][4][2];
#pragma unroll
        for (int ai = 0; ai < 2; ++ai)
#pragma unroll
            for (int m = 0; m < 4; ++m) { const size_t off = (size_t)(u.pm * BM + ai * HALF + wr * 64 + m * 16 + fr) * 1024 + col0;
#pragma unroll
                for (int bj = 0; bj < 2; ++bj) xv[ai][m][bj] = *(const u32x4*)(xb + off + bj * 32); }
#pragma unroll
        for (int ai = 0; ai < 2; ++ai)
#pragma unroll
            for (int m = 0; m < 4; ++m) {
                const int row = u.pm * BM + ai * HALF + wr * 64 + m * 16 + fr; float s = 0.f; u32x4 w[2];
#pragma unroll
                for (int bj = 0; bj < 2; ++bj) {
                    const u32x4 xw = xv[ai][m][bj];
                    const f32x4 h0 = (f32x4){__uint_as_float(xw.x << 16), __uint_as_float(xw.x & 0xffff0000u), __uint_as_float(xw.y << 16), __uint_as_float(xw.y & 0xffff0000u)} + acc[ai][bj][m][0];
                    const f32x4 h1 = (f32x4){__uint_as_float(xw.z << 16), __uint_as_float(xw.z & 0xffff0000u), __uint_as_float(xw.w << 16), __uint_as_float(xw.w & 0xffff0000u)} + acc[ai][bj][m][1];
                    s += (h0[0] * h0[0] + h0[1] * h0[1]) + (h0[2] * h0[2] + h0[3] * h0[3]) + (h1[0] * h1[0] + h1[1] * h1[1]) + (h1[2] * h1[2] + h1[3] * h1[3]);
                    w[bj].x = cvt_pk_bf16(h0[0], h0[1]); w[bj].y = cvt_pk_bf16(h0[2], h0[3]); w[bj].z = cvt_pk_bf16(h1[0], h1[1]); w[bj].w = cvt_pk_bf16(h1[2], h1[3]);
                }
                stage_store16(stg + (wr * 4 + wc) * 2048, hb + (size_t)(row - fr) * 1024 + u.pn * BM + wc * 64, 1024, fr, fq, 4 + fq, w[0], w[1]);
                s += __shfl_xor(s, 16); s += __shfl_xor(s, 32);
                if (fq == 0) atomicAdd(rowss + row, s);
            }
    }
};

struct EpiFF1 {
    static constexpr bool PERM = true, AFTER_DRAIN = false; static constexpr int NSTORE = 16;
    bf16_t* O; const float* rowss; PG8_LAS unsigned char* stg;
    __device__ __forceinline__ void operator()(const f32x4 (&acc)[2][2][4][2], const Unit& u, int wr, int wc, int fr, int fq) const {
        const int col0 = u.pn * BM + wc * 32 + 8 * fq;
        float ssv[2][4];
#pragma unroll
        for (int ai = 0; ai < 2; ++ai)
#pragma unroll
            for (int m = 0; m < 4; ++m) ssv[ai][m] = rowss[u.pm * BM + ai * HALF + wr * 64 + m * 16 + fr];
#pragma unroll
        for (int ai = 0; ai < 2; ++ai)
#pragma unroll
            for (int m = 0; m < 4; ++m) {
                const int row = u.pm * BM + ai * HALF + wr * 64 + m * 16 + fr;
                const float rs2 = __builtin_amdgcn_rcpf(ssv[ai][m] * (1.0f / 1024.0f) + 1e-6f);
                u32x4 w[2];
#pragma unroll
                for (int bj = 0; bj < 2; ++bj) {
                    f32x4 v0 = acc[ai][bj][m][0], v1 = acc[ai][bj][m][1];
#pragma unroll
                    for (int e = 0; e < 4; ++e) { const float a = fmaxf(v0[e], 0.f), b = fmaxf(v1[e], 0.f); v0[e] = a * a * rs2; v1[e] = b * b * rs2; }
                    w[bj].x = cvt_pk_bf16(v0[0], v0[1]); w[bj].y = cvt_pk_bf16(v0[2], v0[3]); w[bj].z = cvt_pk_bf16(v1[0], v1[1]); w[bj].w = cvt_pk_bf16(v1[2], v1[3]);
                }
                stage_store16(stg + (wr * 4 + wc) * 2048, O + (size_t)(row - fr) * 4096 + u.pn * BM + wc * 64, 4096, fr, fq, 4 + fq, w[0], w[1]);
            }
    }
};

struct EpiFF2 {
    static constexpr bool PERM = true, AFTER_DRAIN = false; static constexpr int NSTORE = 32;
    float* out; const bf16_t* hb; PG8_LAS unsigned char* stg;
    __device__ __forceinline__ void operator()(const f32x4 (&acc)[2][2][4][2], const Unit& u, int wr, int wc, int fr, int fq) const {
        const int col0 = u.pn * BM + wc * 32 + 8 * fq;
        u32x4 hv[2][4][2];
#pragma unroll
        for (int ai = 0; ai < 2; ++ai)
#pragma unroll
            for (int m = 0; m < 4; ++m) { const size_t off = (size_t)(u.pm * BM + ai * HALF + wr * 64 + m * 16 + fr) * 1024 + col0;
#pragma unroll
                for (int bj = 0; bj < 2; ++bj) hv[ai][m][bj] = *(const u32x4*)(hb + off + bj * HALF); }
#pragma unroll
        for (int ai = 0; ai < 2; ++ai)
#pragma unroll
            for (int m = 0; m < 4; ++m) { const size_t off = (size_t)(u.pm * BM + ai * HALF + wr * 64 + m * 16 + fr) * 1024 + col0;
#pragma unroll
                for (int bj = 0; bj < 2; ++bj) { const u32x4 hw = hv[ai][m][bj];
                    const f32x4 h0 = (f32x4){__uint_as_float(hw.x << 16), __uint_as_float(hw.x & 0xffff0000u), __uint_as_float(hw.y << 16), __uint_as_float(hw.y & 0xffff0000u)};
                    const f32x4 h1 = (f32x4){__uint_as_float(hw.z << 16), __uint_as_float(hw.z & 0xffff0000u), __uint_as_float(hw.w << 16), __uint_as_float(hw.w & 0xffff0000u)};
                    const f32x4 r0 = h0 + acc[ai][bj][m][0], r1 = h1 + acc[ai][bj][m][1];
                    stage_store16(stg + (wr * 4 + wc) * 2048, (bf16_t*)(out + (off - fr * 1024 - 8 * fq) + bj * HALF), 2048, fr, 2 * fq, 2 * fq + 1, __builtin_bit_cast(u32x4, r0), __builtin_bit_cast(u32x4, r1)); } }
    }
};

template <class Epi, class Sched, bool ALIGN_EPI = false, bool SP2 = false>
__device__ __forceinline__ void gemm_phase(PG8_LAS unsigned char* lds, const Gemm g, const Sched& S, const Epi& E) {
    const int tid = threadIdx.x, wid = __builtin_amdgcn_readfirstlane(tid >> 6), lane = tid & 63, wr = wid >> 2, wc = wid & 3, fr = lane & 15, fq = lane >> 4;
    const int K = g.K, nt = K / BK;
    unsigned voffA[2], voffB[2];
#pragma unroll
    for (int i = 0; i < 2; ++i) { int R, C; stage_rc(tid * 16 + i * 8192, R, C); const int Rb = Epi::PERM ? ((R & ~31) + perm32(R & 31)) : R;
        voffA[i] = (unsigned)(R * K + C) * 2u; voffB[i] = (unsigned)(Rb * K + C) * 2u; }
    const size_t kstep = (size_t)(BK * 2);
    const size_t hstep = (size_t)HALF * K * 2;
    const size_t tstep = 2 * hstep;
    const unsigned ldsw = (unsigned)wid * 1024u;
    const int aoff = lds_byte(wr * 64 + fr, fq * 8), boff = lds_byte(wc * 32 + fr, fq * 8);
#define PG8_SA(b, h) (((b) * 2 + (h)) * HTB)
#define PG8_SB(b, h) ((4 + (b) * 2 + (h)) * HTB)
#define PG8_STAGE(bufoff, gbase, voff) do { _Pragma("unroll") for (int _i = 0; _i < 2; ++_i) \
        __builtin_amdgcn_global_load_lds((const unsigned*)((const char*)(gbase) + (voff)[_i]), (PG8_LAS unsigned*)(lds + (bufoff) + ldsw + _i * 8192), 16, 0, 0); } while (0)
#define PG8_LDA(dst, b, h) do { _Pragma("unroll") for (int m = 0; m < 4; ++m) _Pragma("unroll") for (int k = 0; k < 2; ++k) dst[m][k] = *(const PG8_LAS bf16x8*)(lds + PG8_SA(b, h) + aoff + m * 2048 + k * 1024); } while (0)
#define PG8_LDB(dst, b, h) do { _Pragma("unroll") for (int n = 0; n < 2; ++n) _Pragma("unroll") for (int k = 0; k < 2; ++k) dst[n][k] = *(const PG8_LAS bf16x8*)(lds + PG8_SB(b, h) + boff + n * 2048 + k * 1024); } while (0)
#define PG8_MMA(ai, bj, At, Bt) do { __builtin_amdgcn_s_setprio(1); _Pragma("unroll") for (int m = 0; m < 4; ++m) _Pragma("unroll") for (int n = 0; n < 2; ++n) _Pragma("unroll") for (int k = 0; k < 2; ++k) \
        acc[ai][bj][m][n] = __builtin_amdgcn_mfma_f32_16x16x32_bf16(Bt[n][k], At[m][k], acc[ai][bj][m][n], 0, 0, 0); __builtin_amdgcn_s_setprio(0); } while (0)
#define PG8_WAIT_V(n) asm volatile("s_waitcnt vmcnt(" #n ")" ::: "memory")
#define PG8_WAIT_L(n) asm volatile("s_waitcnt lgkmcnt(" #n ")" ::: "memory")
#define PG8_BAR __builtin_amdgcn_s_barrier()
#define PG8_SCHED __builtin_amdgcn_sched_barrier(0)
    Unit cur, nxt; int ui = 0;
    if (!S.next(0, cur)) return;
    f32x4 acc[2][2][4][2];
#pragma unroll
    for (int a = 0; a < 2; ++a)
#pragma unroll
        for (int b = 0; b < 2; ++b)
#pragma unroll
            for (int m = 0; m < 4; ++m)
#pragma unroll
                for (int n = 0; n < 2; ++n) acc[a][b][m][n] = (f32x4){0.f, 0.f, 0.f, 0.f};
    bf16x8 At[4][2], B0[2][2], B1[2][2];
    const char* cA = (const char*)g.A + (size_t)cur.pm * tstep; const char* cB = (const char*)g.Bt + (size_t)cur.pn * tstep;
    S.a_ready(cur);
    if constexpr (SP2) {
        PG8_STAGE(PG8_SB(0, 0), cB, voffB); PG8_STAGE(PG8_SB(0, 1), cB + hstep, voffB); PG8_STAGE(PG8_SA(0, 0), cA, voffA); PG8_STAGE(PG8_SA(0, 1), cA + hstep, voffA);
        if (wr == 1) PG8_BAR;
        PG8_WAIT_V(2); PG8_BAR;
        PG8_STAGE(PG8_SB(1, 0), cB + kstep, voffB); PG8_STAGE(PG8_SA(1, 0), cA + kstep, voffA); PG8_STAGE(PG8_SB(1, 1), cB + hstep + kstep, voffB);
        PG8_WAIT_V(6); PG8_BAR;
    } else {
        PG8_STAGE(PG8_SB(0, 0), cB, voffB); PG8_STAGE(PG8_SA(0, 0), cA, voffA); PG8_STAGE(PG8_SB(0, 1), cB + hstep, voffB); PG8_STAGE(PG8_SA(0, 1), cA + hstep, voffA);
        if (wr == 1) PG8_BAR;
        PG8_WAIT_V(4); PG8_BAR;
        PG8_STAGE(PG8_SB(1, 0), cB + kstep, voffB); PG8_STAGE(PG8_SA(1, 0), cA + kstep, voffA); PG8_STAGE(PG8_SB(1, 1), cB + hstep + kstep, voffB);
        PG8_WAIT_V(6); PG8_BAR;
    }
    for (;;) {
        const bool has_next = S.next(ui + 1, nxt);
        const char* nA = has_next ? (const char*)g.A + (size_t)nxt.pm * tstep : cA; const char* nB = has_next ? (const char*)g.Bt + (size_t)nxt.pn * tstep : cB;
        for (int t = 0; t < nt; t += 2) {
            const bool last = (t == nt - 2);
            const char* a1 = cA + (size_t)(t + 1) * kstep;
            const char* a2 = last ? nA : cA + (size_t)(t + 2) * kstep; const char* b2 = last ? nB : cB + (size_t)(t + 2) * kstep;
            const char* a3 = a2 + kstep; const char* b3 = b2 + kstep;
            if (last && has_next) S.a_ready(nxt);
            if constexpr (SP2) {
            PG8_LDB(B0, 0, 0); PG8_LDB(B1, 0, 1); PG8_SCHED; PG8_LDA(At, 0, 0); PG8_STAGE(PG8_SA(1, 1), a1 + hstep, voffA);
            PG8_WAIT_V(8); PG8_WAIT_L(0); PG8_BAR; PG8_MMA(0, 0, At, B0); PG8_MMA(0, 1, At, B1); PG8_BAR; PG8_SCHED;
            PG8_LDA(At, 0, 1); PG8_STAGE(PG8_SB(0, 0), b2, voffB); PG8_STAGE(PG8_SB(0, 1), b2 + hstep, voffB); PG8_STAGE(PG8_SA(0, 0), a2, voffA);
            PG8_WAIT_V(8); PG8_WAIT_L(0); PG8_BAR; PG8_MMA(1, 0, At, B0); PG8_MMA(1, 1, At, B1); PG8_BAR; PG8_SCHED;
            PG8_LDB(B0, 1, 0); PG8_LDB(B1, 1, 1); PG8_SCHED; PG8_LDA(At, 1, 0); PG8_STAGE(PG8_SA(0, 1), a2 + hstep, voffA);
            PG8_WAIT_V(8); PG8_WAIT_L(0); PG8_BAR; PG8_MMA(0, 0, At, B0); PG8_MMA(0, 1, At, B1); PG8_BAR; PG8_SCHED;
            PG8_LDA(At, 1, 1); PG8_STAGE(PG8_SB(1, 0), b3, voffB); PG8_STAGE(PG8_SB(1, 1), b3 + hstep, voffB); PG8_STAGE(PG8_SA(1, 0), a3, voffA);
            PG8_WAIT_V(8); PG8_WAIT_L(0); PG8_BAR; PG8_MMA(1, 0, At, B0); PG8_MMA(1, 1, At, B1); PG8_BAR; PG8_SCHED;
            } else {
            PG8_LDB(B0, 0, 0); PG8_SCHED; PG8_LDA(At, 0, 0); PG8_STAGE(PG8_SA(1, 1), a1 + hstep, voffA);
            PG8_WAIT_L(8); PG8_BAR; PG8_WAIT_L(0); PG8_MMA(0, 0, At, B0); PG8_BAR; PG8_SCHED;
            PG8_LDB(B1, 0, 1); PG8_STAGE(PG8_SB(0, 0), b2, voffB);
            PG8_BAR; PG8_WAIT_L(0); PG8_MMA(0, 1, At, B1); PG8_BAR;
            PG8_LDA(At, 0, 1); PG8_STAGE(PG8_SA(0, 0), a2, voffA);
            PG8_BAR; PG8_WAIT_L(0); PG8_MMA(1, 0, At, B0); PG8_BAR; PG8_SCHED;
            PG8_STAGE(PG8_SB(0, 1), b2 + hstep, voffB);
            PG8_WAIT_V(6); PG8_BAR; PG8_MMA(1, 1, At, B1); PG8_BAR;
            PG8_LDB(B0, 1, 0); PG8_SCHED; PG8_LDA(At, 1, 0); PG8_STAGE(PG8_SA(0, 1), a2 + hstep, voffA);
            PG8_WAIT_L(8); PG8_BAR; PG8_WAIT_L(0); PG8_MMA(0, 0, At, B0); PG8_BAR; PG8_SCHED;
            PG8_LDB(B1, 1, 1); PG8_STAGE(PG8_SB(1, 0), b3, voffB);
            PG8_BAR; PG8_WAIT_L(0); PG8_MMA(0, 1, At, B1); PG8_BAR;
            PG8_LDA(At, 1, 1); PG8_STAGE(PG8_SA(1, 0), a3, voffA);
            PG8_BAR; PG8_WAIT_L(0); PG8_MMA(1, 0, At, B0); PG8_BAR; PG8_SCHED;
            PG8_STAGE(PG8_SB(1, 1), b3 + hstep, voffB);
            PG8_WAIT_V(6); PG8_BAR; PG8_MMA(1, 1, At, B1); PG8_BAR;
            }
        }
        if constexpr (ALIGN_EPI) { if (wr == 0) PG8_BAR; }
        if constexpr (!Epi::AFTER_DRAIN) { E(acc, cur, wr, wc, fr, fq); S.done(cur); }
        if (!has_next) break;
#pragma unroll
        for (int a = 0; a < 2; ++a)
#pragma unroll
            for (int b = 0; b < 2; ++b)
#pragma unroll
                for (int m = 0; m < 4; ++m)
#pragma unroll
                    for (int n = 0; n < 2; ++n) acc[a][b][m][n] = (f32x4){0.f, 0.f, 0.f, 0.f};
        cur = nxt; cA = nA; cB = nB; ++ui;
        if constexpr (ALIGN_EPI) { if (wr == 1) PG8_BAR; }
    }
    PG8_WAIT_V(0);
    if constexpr (!ALIGN_EPI) { if (wr == 0) PG8_BAR; }
    PG8_BAR;
    if constexpr (Epi::AFTER_DRAIN) { E.fused(acc, cur, wr, wc, fr, fq, lds, wid, lane); S.done(cur); }
#undef PG8_SA
#undef PG8_SB
#undef PG8_STAGE
#undef PG8_LDA
#undef PG8_LDB
#undef PG8_MMA
#undef PG8_WAIT_V
#undef PG8_WAIT_L
#undef PG8_BAR
#undef PG8_SCHED
}
}

#include <hip/hip_cooperative_groups.h>
namespace cg = cooperative_groups;
#define LAS __attribute__((address_space(3)))
typedef unsigned short bf16;
typedef short bf16x8 __attribute__((ext_vector_type(8)));
typedef short s16x4 __attribute__((ext_vector_type(4)));
typedef float f32x4 __attribute__((ext_vector_type(4)));
typedef float f32x16 __attribute__((ext_vector_type(16)));
typedef unsigned u32x4 __attribute__((ext_vector_type(4)));

#define XB_TMO      128
#define XB_XCNT(j)  (256  + 64 * (j))
#define XB_XSUB(j)  (1280 + 64 * (j))
#define XB_XGEN(j)  (2304 + 64 * (j))
#define XB_TOP      3328
#define XB_TOPGEN   3392
#define XCD_BAR_WORDS 3456
#define XB_SPIN_CAP (1u << 18)

__device__ __forceinline__ unsigned xb_ld(unsigned* p)              { return __hip_atomic_load(p, __ATOMIC_RELAXED, __HIP_MEMORY_SCOPE_AGENT); }
__device__ __forceinline__ unsigned xb_add(unsigned* p, unsigned v) { return __hip_atomic_fetch_add(p, v, __ATOMIC_RELAXED, __HIP_MEMORY_SCOPE_AGENT); }
__device__ __forceinline__ unsigned xb_xcc_id() { return (unsigned)__builtin_amdgcn_s_getreg((3 << 11) | 20) & 0xFu; }
#define XB_SPIN(cond, bar) do { unsigned _sp = 0; while (cond) { __builtin_amdgcn_s_sleep(1); \
    if ((++_sp & 255u) == 0u) { if (xb_ld(&(bar)[XB_TMO])) break; if (_sp > XB_SPIN_CAP) { atomicAdd(&(bar)[XB_TMO], 1u); break; } } } } while (0)

struct XcdBarrier {
    unsigned* bar; unsigned x;
    volatile LAS unsigned* st;
};

__device__ __forceinline__ XcdBarrier xcd_barrier_post(unsigned* bar, volatile LAS unsigned* st) {
    XcdBarrier b; b.bar = bar; b.x = xb_xcc_id(); b.st = st;
    if (threadIdx.x == 0) (void)xb_add(&bar[XB_XCNT(b.x)], 1u);
    return b;
}
__device__ __forceinline__ void xcd_barrier_complete(unsigned* bar, unsigned x, unsigned& nloc, unsigned& nx) {
    const unsigned G = gridDim.x * gridDim.y * gridDim.z;
    unsigned sum, cnt, mine, sp = 0u;
    for (;;) {
        sum = 0u; cnt = 0u; mine = 0u;
#pragma unroll
        for (unsigned j = 0; j < 16; ++j) { const unsigned c = xb_ld(&bar[XB_XCNT(j)]); sum += c; cnt += (c > 0u) ? 1u : 0u; mine = (j == x) ? c : mine; }
        if (sum == G) break;
        __builtin_amdgcn_s_sleep(1);
        if ((++sp & 255u) == 0u) { if (xb_ld(&bar[XB_TMO])) break; if (sp > XB_SPIN_CAP) { atomicAdd(&bar[XB_TMO], 1u); break; } }
    }
    nloc = mine > 0u ? mine : 1u; nx = cnt > 0u ? cnt : 1u;
}

__device__ __forceinline__ void xcd_barrier(const XcdBarrier& b) {
    asm volatile("s_waitcnt vmcnt(0)" ::: "memory");
    __syncthreads();
    if (threadIdx.x == 0) {
        unsigned* bar = b.bar;
        __builtin_amdgcn_s_waitcnt(0);
        unsigned nloc = b.st[0], nx = b.st[1];
        if (nloc == 0u) { xcd_barrier_complete(bar, b.x, nloc, nx); b.st[0] = nloc; b.st[1] = nx; }
        const unsigned old = xb_add(&bar[XB_XSUB(b.x)], 1u);
        const unsigned gen = old / nloc;
        if (old + 1u == (gen + 1u) * nloc) {
            __builtin_amdgcn_fence(__ATOMIC_RELEASE, "agent");
            asm volatile("s_waitcnt vmcnt(0)" ::: "memory");
            const unsigned og = xb_add(&bar[XB_TOP], 1u);
            const unsigned tg = og / nx;
            if (og + 1u == (tg + 1u) * nx) xb_add(&bar[XB_TOPGEN], 1u);
            else XB_SPIN(xb_ld(&bar[XB_TOPGEN]) == tg, bar);
            __builtin_amdgcn_fence(__ATOMIC_ACQUIRE, "agent");
            xb_add(&bar[XB_XGEN(b.x)], 1u);
            asm volatile("s_waitcnt vmcnt(0)" ::: "memory");
        } else {
            XB_SPIN(xb_ld(&bar[XB_XGEN(b.x)]) == gen, bar);
            __builtin_amdgcn_fence(__ATOMIC_ACQUIRE, "agent");
            asm volatile("s_waitcnt vmcnt(0)" ::: "memory");
        }
    }
    __syncthreads();
}
#ifndef P5_ALIGN
#define P5_ALIGN GEMM_ALIGN
#endif
#ifndef GEMM_ALIGN
#define GEMM_ALIGN true
#endif
#ifndef GEMM_SP2
#define GEMM_SP2 true
#endif
constexpr int BATCH = 16, SEQ = 2048, DM = 1024, M = BATCH * SEQ, NIN = 2560, FF = 4096, HD = 64, NH = 8, NG = 8, SW = 512;
constexpr size_t MiB = 1u << 20;
constexpr size_t WS_BAR = 512 * 1024, BAR_BYTES = 16384;
constexpr size_t WS_RS1 = 256 * 1024;
constexpr size_t WS_ROWSS = 0, WS_WIN = 1 * MiB, WS_WO = 6 * MiB, WS_W1 = 8 * MiB, WS_W2 = 16 * MiB, WS_WSG = 24 * MiB  , WS_HB = 32 * MiB, WS_XN = 96 * MiB, WS_SEC = 160 * MiB, WS_MIX = 320 * MiB, WS_A2 = 96 * MiB, WS_END = 384 * MiB;
constexpr size_t SEC_ELEMS = (size_t)M * SW;
constexpr int NWAVES = 8, LDS_BYTES = 155648;
constexpr int EPI_STG = 131072 + 4096;

__device__ __forceinline__ unsigned pk2(float lo, float hi) { return pg8::cvt_pk_bf16(lo, hi); }
__device__ __forceinline__ float wave_sum(float v) {
#pragma unroll
    for (int o = 1; o < 64; o <<= 1) v += __shfl_xor(v, o);
    return v;
}
__device__ __forceinline__ float bf2f(unsigned short b) { return __uint_as_float((unsigned)b << 16); }

__device__ __forceinline__ int hperm_row(int n) { const int t = n >> 8, nl = n & 255; return t * 256 + ((nl >> 5) & 1) * 128 + (nl >> 6) * 32 + (nl & 31); }
struct P0Item { const float* W; bf16* WT; const float* ksc; int K, N, r; bool hperm; };
__device__ __forceinline__ void p0_item_load(const P0Item& I, f32x4 (&wv)[8], int lane) {
    const int nblk = I.N / 32, kb = I.r / nblk, nb = I.r % nblk, k0 = 64 * kb, n0 = 32 * nb;
#pragma unroll
    for (int i = 0; i < 8; ++i) wv[i] = *(const f32x4*)(I.W + (size_t)(k0 + (lane >> 3) + 8 * i) * I.N + n0 + 4 * (lane & 7));
}
__device__ __forceinline__ void p0_item_store(const P0Item& I, const f32x4 (&wv)[8], LAS float* scr, int lane) {
    const int nblk = I.N / 32, kb = I.r / nblk, nb = I.r % nblk, k0 = 64 * kb, n0 = 32 * nb;
#pragma unroll
    for (int i = 0; i < 8; ++i) { const int kk = (lane >> 3) + 8 * i; f32x4 w = wv[i]; if (I.ksc) w = w * I.ksc[k0 + kk];
        LAS float* d = scr + kk * 33 + 4 * (lane & 7); d[0] = w[0]; d[1] = w[1]; d[2] = w[2]; d[3] = w[3]; }
    asm volatile("s_waitcnt lgkmcnt(0)" ::: "memory");
    const int c = lane & 7; const int r0 = I.hperm ? hperm_row(n0) : n0;
#pragma unroll
    for (int j = 0; j < 4; ++j) { const int n = (lane >> 3) + 8 * j; const LAS float* s = scr + (8 * c) * 33 + n;
        u32x4 o; o.x = pk2(s[0 * 33], s[1 * 33]); o.y = pk2(s[2 * 33], s[3 * 33]); o.z = pk2(s[4 * 33], s[5 * 33]); o.w = pk2(s[6 * 33], s[7 * 33]);
        *(u32x4*)(I.WT + (size_t)(r0 + n) * I.K + k0 + 8 * c) = o; }
    asm volatile("s_waitcnt lgkmcnt(0)" ::: "memory");
}
struct Ptrs {
    const float *x, *g1, *win, *gq, *gk, *gvs, *sgw, *sgb, *gsb, *gsg, *wout, *g2, *w1, *w2;
    float* out; unsigned char* ws;
};
__device__ __forceinline__ void p0_prologue(const Ptrs& P, LAS unsigned char* lds, int vcu, int G, int wave, int lane) {
    LAS float* scr = (LAS float*)(lds + wave * 16384);
    const int gw = vcu * NWAVES + wave, NGW = G * NWAVES;
    constexpr int I_IN = (DM / 64) * (NIN / 32), I_O = (DM / 64) * (DM / 32), I_1 = (DM / 64) * (FF / 32), I_2 = (FF / 64) * (DM / 32);
    constexpr int NITEMS = I_IN + I_O + I_1 + I_2;
    bf16* Win_t = (bf16*)(P.ws + WS_WIN); bf16* Wo_t = (bf16*)(P.ws + WS_WO); bf16* W1_t = (bf16*)(P.ws + WS_W1); bf16* W2_t = (bf16*)(P.ws + WS_W2);
#define P0_DECODE(I, it_) do { int r_ = (it_); \
        if (r_ < I_IN) { I.W = P.win; I.WT = Win_t; I.ksc = P.g1; I.K = DM; I.N = NIN; I.hperm = true; } \
        else if ((r_ -= I_IN) < I_O) { I.W = P.wout; I.WT = Wo_t; I.ksc = nullptr; I.K = DM; I.N = DM; I.hperm = true; } \
        else if ((r_ -= I_O) < I_1) { I.W = P.w1; I.WT = W1_t; I.ksc = P.g2; I.K = DM; I.N = FF; I.hperm = true; } \
        else { r_ -= I_1; I.W = P.w2; I.WT = W2_t; I.ksc = nullptr; I.K = FF; I.N = DM; I.hperm = false; } \
        I.r = r_; } while (0)

    if (gw < NITEMS) {
        P0Item C, Nx; f32x4 wv[8], wn[8];
        P0_DECODE(C, gw); p0_item_load(C, wv, lane);
        for (int it = gw; it < NITEMS; it += NGW) {
            const bool more = it + NGW < NITEMS;
            if (more) { P0_DECODE(Nx, it + NGW); p0_item_load(Nx, wn, lane); }
            p0_item_store(C, wv, scr, lane);
            if (more) { C = Nx;
#pragma unroll
                for (int i = 0; i < 8; ++i) wv[i] = wn[i]; }
        }
    }
#undef P0_DECODE

    for (int it = gw; it < 256; it += NGW) { const int idx = it * 512 + lane * 8, t = (idx >> 7) & 127, s0 = idx & 127;
        const f32x4 a = *(const f32x4*)(P.sgw + idx), c4 = *(const f32x4*)(P.sgw + idx + 4);
        float w[8] = {a[0], a[1], a[2], a[3], c4[0], c4[1], c4[2], c4[3]};
#pragma unroll
        for (int j = 0; j < 8; ++j) if (s0 + j > t) w[j] = 0.f;
        *(u32x4*)((bf16*)(P.ws + WS_WSG) + idx) = (u32x4){pk2(w[0], w[1]), pk2(w[2], w[3]), pk2(w[4], w[5]), pk2(w[6], w[7])}; }

    bf16* XN = (bf16*)(P.ws + WS_XN); float* rowss = (float*)(P.ws + WS_ROWSS); float* rs1 = (float*)(P.ws + WS_RS1);
    f32x4 gv[4];
#pragma unroll
    for (int j = 0; j < 4; ++j) gv[j] = ((const f32x4*)P.g1)[lane + 64 * j];
    for (int m0 = 8 * gw; m0 < M; m0 += 8 * NGW) {
        f32x4 v[8][4];
#pragma unroll
        for (int i = 0; i < 8; ++i) { const f32x4* xr = (const f32x4*)(P.x + (size_t)(m0 + i) * DM) + lane;
#pragma unroll
            for (int j = 0; j < 4; ++j) v[i][j] = xr[64 * j]; }
#pragma unroll
        for (int i = 0; i < 8; ++i) { const int m = m0 + i; float s = 0.f;
#pragma unroll
            for (int j = 0; j < 4; ++j) s += (v[i][j].x * v[i][j].x + v[i][j].y * v[i][j].y) + (v[i][j].z * v[i][j].z + v[i][j].w * v[i][j].w);
            const float rs = __builtin_amdgcn_rsqf(wave_sum(s) * (1.f / DM) + 1e-6f);
            unsigned long long* o8 = (unsigned long long*)(XN + (size_t)m * DM) + lane;
#pragma unroll
            for (int j = 0; j < 4; ++j) { const f32x4 t = v[i][j]; o8[64 * j] = (unsigned long long)pk2(t.x, t.y) | ((unsigned long long)pk2(t.z, t.w) << 32); }
            if (lane == 0) { rowss[m] = 0.f; rs1[m] = rs; } }
    }

}

constexpr int AT_K = 0, AT_V = 16384, AT_STG = 32768, AT_STG_W = 32 * 68 * 4;
__device__ __forceinline__ int crow(int r, int hi) { return (r & 3) + 8 * (r >> 2) + 4 * hi; }
__device__ __forceinline__ s16x4 vtr(const LAS char* p) { typedef short v4i16_t __attribute__((ext_vector_type(4))); return __builtin_bit_cast(s16x4, __builtin_amdgcn_ds_read_tr16_b64_v4i16((LAS v4i16_t*)p)); }

template <bool MASK>
__device__ __forceinline__ void attn_scores(f32x16& p0, f32x16& p1, float& Racc, int dq  , int hi, u32x4 (&pw)[4]) {
    f32x16 s0, s1;
#pragma unroll
    for (int r = 0; r < 16; ++r) {
        float a = __builtin_amdgcn_logf(1.0f + __builtin_amdgcn_exp2f(p0[r])), b = __builtin_amdgcn_logf(1.0f + __builtin_amdgcn_exp2f(p1[r]));
        if (MASK) { const int kr = (r & 3) + 8 * (r >> 2); if (!(kr < dq)) a = 0.f; if (!(kr + 32 < dq)) b = 0.f; }
        s0[r] = a; s1[r] = b;
    }
#pragma unroll
    for (int g = 0; g < 4; ++g) {
        s0[4 * g + 2] += s0[4 * g + 3]; s0[4 * g + 1] += s0[4 * g + 2]; s0[4 * g] += s0[4 * g + 1];
        s1[4 * g + 2] += s1[4 * g + 3]; s1[4 * g + 1] += s1[4 * g + 2]; s1[4 * g] += s1[4 * g + 1];
    }
    float g1v[8], H[8];
#pragma unroll
    for (int i = 0; i < 8; ++i) {
        const float t = i < 4 ? s0[4 * i] : s1[4 * (i - 4)];
        auto rr = __builtin_amdgcn_permlane32_swap(__float_as_uint(t), __float_as_uint(t), false, false);
        const float lo = __uint_as_float(rr[0]), hh = __uint_as_float(rr[1]);
        g1v[i] = hh; H[i] = lo + hh;
    }
    float off[8]; float sfx = 0.f;
#pragma unroll
    for (int i = 7; i >= 0; --i) { off[i] = sfx + Racc + (hi == 0 ? g1v[i] : 0.f); sfx += H[i]; }
    Racc += sfx;
#pragma unroll
    for (int r = 0; r < 16; ++r) {
        float a = __builtin_amdgcn_exp2f(p0[r] - (s0[r] + off[r >> 2])), b = __builtin_amdgcn_exp2f(p1[r] - (s1[r] + off[4 + (r >> 2)]));
        if (MASK) { const int kr = (r & 3) + 8 * (r >> 2); if (!(kr < dq)) a = 0.f; if (!(kr + 32 < dq)) b = 0.f; }
        p0[r] = a; p1[r] = b;
    }
#pragma unroll
    for (int ks = 0; ks < 4; ++ks) {
        const int b8 = 8 * (ks & 1);
        if (ks < 2) pw[ks] = (u32x4){pk2(p0[b8], p0[b8 + 1]), pk2(p0[b8 + 2], p0[b8 + 3]), pk2(p0[b8 + 4], p0[b8 + 5]), pk2(p0[b8 + 6], p0[b8 + 7])};
        else        pw[ks] = (u32x4){pk2(p1[b8], p1[b8 + 1]), pk2(p1[b8 + 2], p1[b8 + 3]), pk2(p1[b8 + 4], p1[b8 + 5]), pk2(p1[b8 + 6], p1[b8 + 7])};
    }
}
__device__ __forceinline__ void attn_pv(f32x16 (&o)[2], const u32x4 (&pw)[4], const LAS char* vp) {
#pragma unroll
    for (int ks = 0; ks < 4; ++ks)
#pragma unroll
        for (int d0 = 0; d0 < 2; ++d0) {
            const s16x4 lo = vtr(vp + d0 * 4096 + ks * 1024), hh = vtr(vp + d0 * 4096 + ks * 1024 + 512);
            const bf16x8 vf = (bf16x8){lo[0], lo[1], lo[2], lo[3], hh[0], hh[1], hh[2], hh[3]};
            o[d0] = __builtin_amdgcn_mfma_f32_32x32x16_bf16(vf, __builtin_bit_cast(bf16x8, pw[ks]), o[d0], 0, 0, 0);
        }
}
__device__ __forceinline__ void glds16(const void* gsrc, unsigned lds_dst) { unsigned keep;
    asm volatile("s_mov_b32 %0, m0\n\ts_mov_b32 m0, %2\n\ts_nop 0\n\tglobal_load_lds_dwordx4 %1, off\n\ts_mov_b32 m0, %0" : "=&s"(keep) : "v"(gsrc), "s"(lds_dst) : "memory"); }
#ifndef ATTN_EXIT_THR
#define ATTN_EXIT_THR 150.0f
#endif
__device__ __forceinline__ void attn_wave(int b, int h, int rb, const bf16* Q, const bf16* K, const bf16* V, bf16* MIX, const float* gout, LAS char* wl) {

    const int lane = threadIdx.x & 63, r32 = lane & 31, hi = lane >> 5;
    const size_t rowbase = (size_t)b * SEQ; const int qw0 = rb * 32;
    const bf16* Qw = Q + (rowbase + qw0) * SW + h * HD;
    const bf16* ksrc = K + (rowbase + (lane >> 3)) * SW + h * HD;
    const int kch0 = ((lane & 7) ^ (lane >> 4)) * 8, kch1 = ((lane & 7) ^ (4 + (lane >> 4))) * 8;
    const bf16* vsrc = V + (rowbase + (lane >> 2)) * SW + h * HD + (lane & 3) * 8;
    const LAS char* kp0 = wl + r32 * 128; const int ksw = (r32 >> 1) & 7;
    const LAS char* vp0 = wl + 8192 + ((lane >> 4) & 1) * 32 + (lane & 3) * 8 + (4 * hi + ((lane & 15) >> 2)) * 64;
    const int NTw = (qw0 + 30) / 64 + 1;
    bf16x8 qr[4];
#pragma unroll
    for (int d0 = 0; d0 < 4; ++d0) qr[d0] = *(const bf16x8*)(Qw + (size_t)r32 * SW + d0 * 16 + hi * 8);
    const unsigned kdma = (unsigned)__builtin_amdgcn_readfirstlane((int)(unsigned)(uintptr_t)wl), vdma = kdma + 8192u;
#define AT_DMAK(t) do { const bf16* kq_ = ksrc + (size_t)(t) * 64 * SW; _Pragma("unroll") for (int c_ = 0; c_ < 8; ++c_) glds16(kq_ + (size_t)(8 * c_) * SW + ((c_ & 1) ? kch1 : kch0), kdma + c_ * 1024); } while (0)
#define AT_DMAV(t) do { const bf16* vq_ = vsrc + (size_t)(t) * 64 * SW; _Pragma("unroll") for (int c_ = 0; c_ < 8; ++c_) glds16(vq_ + (size_t)(16 * (c_ & 3)) * SW + (c_ >> 2) * 32, vdma + c_ * 1024); } while (0)
#define AT_QK(P0, P1) do { _Pragma("unroll") for (int d0 = 0; d0 < 4; ++d0) { const LAS char* kq = kp0 + (((2 * d0 + hi) ^ ksw) * 16); \
        const bf16x8 b0 = *(const LAS bf16x8*)kq, b1 = *(const LAS bf16x8*)(kq + 4096); \
        P0 = __builtin_amdgcn_mfma_f32_32x32x16_bf16(b0, qr[d0], P0, 0, 0, 0); P1 = __builtin_amdgcn_mfma_f32_32x32x16_bf16(b1, qr[d0], P1, 0, 0, 0); } } while (0)
    asm volatile("s_waitcnt lgkmcnt(0)" ::: "memory");
    AT_DMAK(NTw - 1);
    f32x16 o[2]; o[0] = (f32x16){}; o[1] = (f32x16){};
    float Racc = 0.f;
    f32x16 p0 = (f32x16){}, p1 = (f32x16){};
    asm volatile("s_waitcnt vmcnt(0)" ::: "memory");
    AT_QK(p0, p1);
    asm volatile("s_waitcnt lgkmcnt(0)" ::: "memory");
    if (NTw >= 2) AT_DMAK(NTw - 2);

    u32x4 pw[4];
    int t = NTw - 1;
    for (;; --t) {
        asm volatile("s_waitcnt vmcnt(0)" ::: "memory");
        if (t < NTw - 1) attn_pv(o, pw, vp0);
        f32x16 n0 = (f32x16){}, n1 = (f32x16){};
        if (t > 0) AT_QK(n0, n1);
        asm volatile("s_waitcnt lgkmcnt(0)" ::: "memory");
        AT_DMAV(t);
        if (t >= 2) AT_DMAK(t - 2);
        __builtin_amdgcn_sched_barrier(0);
        const int kv0 = 64 * t, dq = qw0 + r32 - kv0 - 4 * hi;
        if (kv0 + 64 <= qw0) attn_scores<false>(p0, p1, Racc, dq, hi, pw);
        else                 attn_scores<true>(p0, p1, Racc, dq, hi, pw);
        if (__all(Racc > ATTN_EXIT_THR) || t == 0) break;
        p0 = n0; p1 = n1;
    }

    asm volatile("s_waitcnt vmcnt(0)" ::: "memory");
    attn_pv(o, pw, vp0);
#undef AT_DMAK
#undef AT_DMAV
#undef AT_QK
    float ss = 0.f;
#pragma unroll
    for (int r = 0; r < 16; ++r) ss += o[0][r] * o[0][r] + o[1][r] * o[1][r];
    { auto rr = __builtin_amdgcn_permlane32_swap(__float_as_uint(ss), __float_as_uint(ss), false, false); ss = __uint_as_float(rr[0]) + __uint_as_float(rr[1]); }
    const float rs = __builtin_amdgcn_rsqf(ss * (1.f / 64.f) + 1e-6f);
    f32x4 gg[2][4];
#pragma unroll
    for (int d0 = 0; d0 < 2; ++d0)
#pragma unroll
        for (int g4 = 0; g4 < 4; ++g4) gg[d0][g4] = *(const f32x4*)(gout + 32 * d0 + 8 * g4 + 4 * hi);
    asm volatile("s_waitcnt lgkmcnt(0)" ::: "memory");
    typedef unsigned u32x2_t __attribute__((ext_vector_type(2)));
#pragma unroll
    for (int d0 = 0; d0 < 2; ++d0)
#pragma unroll
        for (int g4 = 0; g4 < 4; ++g4) {
            u32x2_t w; w.x = pk2(o[d0][4 * g4] * rs * gg[d0][g4][0], o[d0][4 * g4 + 1] * rs * gg[d0][g4][1]); w.y = pk2(o[d0][4 * g4 + 2] * rs * gg[d0][g4][2], o[d0][4 * g4 + 3] * rs * gg[d0][g4][3]);
            *(LAS u32x2_t*)(wl + r32 * 128 + (((4 * d0 + g4) ^ (r32 & 7)) * 16) + 8 * hi) = w;
        }
    asm volatile("s_waitcnt lgkmcnt(0)" ::: "memory");
    bf16* obase = MIX + (rowbase + qw0) * DM + h * HD;
#pragma unroll
    for (int i = 0; i < 4; ++i) { const int row = i * 8 + (lane >> 3), ch = lane & 7;
        const u32x4 v = *(const LAS u32x4*)(wl + row * 128 + ((ch ^ (row & 7)) * 16));
        *(u32x4*)(obase + (size_t)row * DM + ch * 8) = v; }
    asm volatile("s_waitcnt lgkmcnt(0)" ::: "memory");
}

constexpr int SG_VN = 0, SG_VNB = 16384, SG_STG = 32768;
struct SgPre { bf16x8 wf[8]; u32x4 u0, u1; float bias; };
__device__ __forceinline__ void sg_prefetch(SgPre& R, int item, const bf16* VS, const bf16* U, const bf16* wsg, const float* sgb, unsigned vn_lds, int wid, int lane, bool do_w) {
    const int g = item & 7, c = (item >> 3) & 15, b = item >> 7, tid = wid * 64 + lane;
    const size_t row0 = (size_t)b * SEQ + 128 * c;
#pragma unroll
    for (int i = 0; i < 2; ++i) { const int p = 2 * wid + i, dh = p >> 3, q = p & 7;
        glds16(VS + (row0 + 16 * q + (lane >> 2)) * SW + 64 * g + dh * 32 + (lane & 3) * 8, vn_lds + p * 1024); }
    const int r32 = lane & 31, hi = lane >> 5, tb = wid >> 1, t = 32 * tb + r32;
    const bf16* wrow = wsg + ((size_t)g * 128 + t) * 128 + 8 * hi;
    const int row = tid >> 2, part = tid & 3;
    if (do_w) {
#pragma unroll
        for (int ks = 0; ks < 8; ++ks) R.wf[ks] = *(const bf16x8*)(wrow + 16 * ks);
        R.bias = sgb[g * 128 + row];
    }
    R.u0 = *(const u32x4*)(U + (row0 + row) * SW + 64 * g + part * 16); R.u1 = *(const u32x4*)(U + (row0 + row) * SW + 64 * g + part * 16 + 8);
}
__device__ __forceinline__ void sg_phase(int first, int stride, int n_items, const bf16* VS, const bf16* U, const bf16* wsg, const float* sgb, const float* gout, bf16* MIX, LAS char* shm) {
    const int tid = threadIdx.x, lane = tid & 63, r32 = lane & 31, hi = lane >> 5; const int wid = __builtin_amdgcn_readfirstlane(tid >> 6);
    const unsigned lds0 = (unsigned)__builtin_amdgcn_readfirstlane((int)(unsigned)(uintptr_t)shm);
    const int tb = wid >> 1, dh = wid & 1, nks = 2 * tb + 2;
    const int row = tid >> 2, part = tid & 3;
    if (first >= n_items) return;
    f32x4 gg[4];
#pragma unroll
    for (int q = 0; q < 4; ++q) gg[q] = *(const f32x4*)(gout + part * 16 + 4 * q);
    SgPre N;
    const bool same_g = (stride & 7) == 0;
    sg_prefetch(N, first, VS, U, wsg, sgb, lds0 + SG_VN, wid, lane, true);
    int k = 0;
    for (int item = first; item < n_items; item += stride, ++k) {
        const SgPre C = N;
        asm volatile("s_waitcnt vmcnt(2)" ::: "memory");
        __syncthreads();
        const int buf = (k & 1) * 16384;
        if (item + stride < n_items) sg_prefetch(N, item + stride, VS, U, wsg, sgb, lds0 + (buf ^ 16384), wid, lane, !same_g);
        const int g = item & 7, c = (item >> 3) & 15, b = item >> 7;
        const size_t row0 = (size_t)b * SEQ + 128 * c;
        f32x16 acc = (f32x16){};
        const LAS char* vp = shm + buf + dh * 8192 + (8 * hi + ((lane & 15) >> 2)) * 64 + ((lane >> 4) & 1) * 32 + (lane & 3) * 8;
#pragma unroll
        for (int ks = 0; ks < 8; ++ks) {
            if (ks < nks) {
                const s16x4 lo = vtr(vp + ks * 1024), hh = vtr(vp + ks * 1024 + 256);
                const bf16x8 vf = (bf16x8){lo[0], lo[1], lo[2], lo[3], hh[0], hh[1], hh[2], hh[3]};
                acc = __builtin_amdgcn_mfma_f32_32x32x16_bf16(C.wf[ks], vf, acc, 0, 0, 0);
            }
        }
        LAS float* stg = (LAS float*)(shm + SG_STG);
#pragma unroll
        for (int r = 0; r < 16; ++r) stg[(32 * tb + crow(r, hi)) * 68 + 32 * dh + r32] = acc[r];
        __syncthreads();
        float val[16]; float s = 0.f;
#pragma unroll
        for (int q = 0; q < 4; ++q) {
            const f32x4 y = *(const LAS f32x4*)(stg + row * 68 + part * 16 + 4 * q);
            const unsigned ua = q < 2 ? C.u0[2 * (q & 1)] : C.u1[2 * (q & 1)], ub = q < 2 ? C.u0[2 * (q & 1) + 1] : C.u1[2 * (q & 1) + 1];
            val[4 * q + 0] = __uint_as_float(ua << 16) * (y[0] + C.bias); val[4 * q + 1] = __uint_as_float(ua & 0xffff0000u) * (y[1] + C.bias);
            val[4 * q + 2] = __uint_as_float(ub << 16) * (y[2] + C.bias); val[4 * q + 3] = __uint_as_float(ub & 0xffff0000u) * (y[3] + C.bias);
        }
#pragma unroll
        for (int e = 0; e < 16; ++e) s += val[e] * val[e];
        s += __shfl_xor(s, 1); s += __shfl_xor(s, 2);
        const float rs = __builtin_amdgcn_rsqf(s * (1.f / 64.f) + 1e-6f);
        u32x4 w0, w1;
#pragma unroll
        for (int q = 0; q < 4; ++q) {
            const unsigned lo = pk2(val[4 * q] * rs * gg[q][0], val[4 * q + 1] * rs * gg[q][1]), hh = pk2(val[4 * q + 2] * rs * gg[q][2], val[4 * q + 3] * rs * gg[q][3]);
            if (q < 2) { w0[2 * q] = lo; w0[2 * q + 1] = hh; } else { w1[2 * (q - 2)] = lo; w1[2 * (q - 2) + 1] = hh; }
        }
        bf16* op = MIX + (row0 + row) * DM + 512 + 64 * g + part * 16;
        *(u32x4*)op = w0; *(u32x4*)(op + 8) = w1;
    }
}

struct Args { Ptrs p; int ph_lo, ph_hi; };
__global__ void __launch_bounds__(NWAVES * 64, 2) mega_fwd(Args args) {
    extern __shared__ __attribute__((aligned(16))) unsigned char lds_raw[];
    cg::grid_group grid = cg::this_grid();
    LAS unsigned char* lds = (LAS unsigned char*)lds_raw;
    const Ptrs& P = args.p;
    const int tid = threadIdx.x, lane = tid & 63, wave = __builtin_amdgcn_readfirstlane(tid >> 6);
    const int G = gridDim.x, bx = blockIdx.x, vcu = (G % 8 == 0) ? (bx % 8) * (G / 8) + bx / 8 : bx;
    const int lo = args.ph_lo, hi = args.ph_hi;
    unsigned char* ws = P.ws;
    bf16* SEC = (bf16*)(ws + WS_SEC); bf16* MIX = (bf16*)(ws + WS_MIX); bf16* HB = (bf16*)(ws + WS_HB); bf16* XN = (bf16*)(ws + WS_XN); bf16* A2 = (bf16*)(ws + WS_A2);
    float* rowss = (float*)(ws + WS_ROWSS);
    volatile LAS unsigned* MISC = (volatile LAS unsigned*)(lds + 131072 + 320);
    if (tid < 32) MISC[tid] = 0u;
    __syncthreads();
    const XcdBarrier bar = xcd_barrier_post((unsigned*)(ws + WS_BAR), MISC + 8);
    if (lo < 0) grid.sync();
#define IN(k) (lo <= (k) && (k) < hi)
#define SEAM(k) do { if (IN(k) && IN((k) + 1)) xcd_barrier(bar); } while (0)
    if (IN(0)) p0_prologue(P, lds, vcu, G, wave, lane);
    SEAM(0);

    if (IN(1)) {
        pg8::Gemm g{XN, (const bf16*)(ws + WS_WIN), M, NIN, DM}; pg8::StaticOrder S; S.init(M, NIN, G, bx);
        pg8::EpiProj E{SEC, SEC_ELEMS, P.gq, P.gk, P.gvs, (const float*)(ws + WS_RS1), lds + EPI_STG};
        pg8::gemm_phase<pg8::EpiProj, pg8::StaticOrder, GEMM_ALIGN, GEMM_SP2>(lds, g, S, E);
    }
    SEAM(1);

    if (IN(2)) {
        const bf16 *Qs = SEC, *Ks = SEC + SEC_ELEMS, *Vs = SEC + 2 * SEC_ELEMS, *Us = SEC + 3 * SEC_ELEMS, *VSs = SEC + 4 * SEC_ELEMS;
        for (int pid = vcu * NWAVES + wave; pid < BATCH * NH * 32; pid += G * NWAVES) {
            const int bh = pid >> 5, j = pid & 31;
            attn_wave(bh / NH, bh % NH, 63 - j, Qs, Ks, Vs, MIX, P.gsb, (LAS char*)lds + wave * 16384);
            attn_wave(bh / NH, bh % NH, j, Qs, Ks, Vs, MIX, P.gsb, (LAS char*)lds + wave * 16384);
        }
        __syncthreads();
        sg_phase(vcu, G, BATCH * 16 * NG, VSs, Us, (const bf16*)(ws + WS_WSG), P.sgb, P.gsg, MIX, (LAS char*)lds);
        __syncthreads();
    }
    SEAM(2);

    if (IN(3)) {
        pg8::Gemm g{MIX, (const bf16*)(ws + WS_WO), M, DM, DM}; pg8::StaticOrder S; S.init(M, DM, G, bx);
        pg8::EpiOut E{XN, HB, rowss, lds + EPI_STG};
        pg8::gemm_phase<pg8::EpiOut, pg8::StaticOrder, GEMM_ALIGN, GEMM_SP2>(lds, g, S, E);
    }
    SEAM(3);

    if (IN(4)) {
        pg8::Gemm g{HB, (const bf16*)(ws + WS_W1), M, FF, DM}; pg8::StaticOrder S; S.init(M, FF, G, bx);
        pg8::EpiFF1 E{A2, rowss, lds + EPI_STG};
        pg8::gemm_phase<pg8::EpiFF1, pg8::StaticOrder, GEMM_ALIGN, GEMM_SP2>(lds, g, S, E);
    }
    SEAM(4);

    if (IN(5)) {
        pg8::Gemm g{A2, (const bf16*)(ws + WS_W2), M, DM, FF}; pg8::StaticOrder S; S.init(M, DM, G, bx);
        pg8::EpiFF2 E{P.out, HB, lds + EPI_STG};
        pg8::gemm_phase<pg8::EpiFF2, pg8::StaticOrder, P5_ALIGN, GEMM_SP2>(lds, g, S, E);
    }
#undef IN
#undef SEAM
}

extern "C" void kernel_launch(void* const* d_in, const int* in_sizes, int n_in, void* d_out, int out_size, void* d_ws, size_t ws_size, hipStream_t stream) {
    static int grid = 0;
    if (grid == 0) {
        if (n_in != 14 || in_sizes[0] != M * DM || out_size != M * DM || ws_size < WS_END) { fprintf(stderr, "kernel_launch: unexpected shapes / workspace (n_in %d, ws %zu)\n", n_in, ws_size); grid = -1; return; }
        int dev = 0, cus = 0, per_cu = 0;
        hipGetDevice(&dev); hipDeviceGetAttribute(&cus, hipDeviceAttributeMultiprocessorCount, dev);
        hipFuncSetAttribute((const void*)mega_fwd, hipFuncAttributeMaxDynamicSharedMemorySize, LDS_BYTES);
        hipOccupancyMaxActiveBlocksPerMultiprocessor(&per_cu, (const void*)mega_fwd, NWAVES * 64, LDS_BYTES);
        if (per_cu < 1) { fprintf(stderr, "kernel_launch: occupancy query says %d blocks per CU\n", per_cu); per_cu = 1; }
        (void)hipGetLastError();
        grid = cus;
        if (M % (8 * grid * NWAVES) != 0) { fprintf(stderr, "kernel_launch: %d CUs: the prologue's row loop needs M %% (64 * CUs) == 0; nothing launched\n", cus); grid = -1; return; }
    }
    if (grid < 0) return;
    Args a{};
    const float** pp = (const float**)&a.p;
    for (int i = 0; i < 14; ++i) pp[i] = (const float*)d_in[i];
    a.p.out = (float*)d_out; a.p.ws = (unsigned char*)d_ws;
#ifndef PH_RANGES
#define PH_RANGES {0, 6}
#endif
    const int rng[] = PH_RANGES;
    for (int li = 0; li < (int)(sizeof(rng) / sizeof(int)) / 2; ++li) {
        a.ph_lo = rng[2 * li]; a.ph_hi = rng[2 * li + 1];
        if (hipMemsetAsync((char*)d_ws + WS_BAR, 0, BAR_BYTES, stream) != hipSuccess) { fprintf(stderr, "kernel_launch: memset failed\n"); break; }
        void* kargs[] = {&a};
        hipError_t e = hipLaunchCooperativeKernel((const void*)mega_fwd, dim3(grid), dim3(NWAVES * 64), kargs, LDS_BYTES, stream);
        if (e != hipSuccess) { fprintf(stderr, "kernel_launch: cooperative launch failed: %s\n", hipGetErrorString(e)); break; }
    }
}
```
